# Optimizing an MI355X kernel written in HIP

```python
import math
import jax, jax.numpy as jnp
from jax import lax
import numpy as np

D_MODEL = 1024
BATCH = 8
SEQ = 2048
DEPTH = 4

HEAD_DIM = 64
N_HEADS = D_MODEL // HEAD_DIM
FOX_HEADS = N_HEADS // 2
NSA_HEADS = N_HEADS - FOX_HEADS
NSA_KV_GROUPS = 2
NSA_GQA = NSA_HEADS // NSA_KV_GROUPS
SB_HEADS = N_HEADS
CMP_BLOCK = 32
CMP_STRIDE = 16
SLC_BLOCK = 64
SLC_TOPK = 8
WINDOW = 256
Q_BLOCK = 128
N_BUCKETS = 32
MAX_DISTANCE = 128
XA_HEADS = 4
XA_HEAD_DIM = 128
XA_WIDTH = XA_HEADS * XA_HEAD_DIM
MEM_LEN = 256
D_FF = 4 * D_MODEL
EPS = 1e-6
NEG = -1e30
FORCED_SCORE = 1e4
FORGET_BIAS_INIT = 4.0

FOX_W = FOX_HEADS * HEAD_DIM
NSA_W = NSA_HEADS * HEAD_DIM
KV_W = NSA_KV_GROUPS * HEAD_DIM
EVEN_SPLITS = [FOX_W, FOX_W, FOX_W, FOX_HEADS, NSA_W, KV_W, KV_W, KV_W, KV_W, KV_W, KV_W, 3 * NSA_HEADS]
EVEN_PROJ = sum(EVEN_SPLITS)
EVEN_OFFSETS = [int(o) for o in np.cumsum(EVEN_SPLITS)[:-1]]
ODD_PROJ = 3 * SB_HEADS * HEAD_DIM

kernel_name = 'hybrid_fox_nsa_stickbreaking_trunk'


def rmsnorm(x, g):
    xf = x.astype(jnp.float32)
    y = xf * lax.rsqrt(jnp.mean(xf * xf, axis=-1, keepdims=True) + EPS)
    return (y * g.astype(jnp.float32)).astype(x.dtype)


def t5_bucket(dist):
    dist = jnp.maximum(dist, 0)
    max_exact = N_BUCKETS // 2
    d_f = jnp.maximum(dist, 1).astype(jnp.float32)
    large = max_exact + (jnp.log(d_f / max_exact) / math.log(MAX_DISTANCE / max_exact)
                         * (N_BUCKETS - max_exact)).astype(jnp.int32)
    large = jnp.minimum(large, N_BUCKETS - 1)
    return jnp.where(dist < max_exact, dist, large)


def _heads(a, n):
    return a.reshape(a.shape[0], a.shape[1], n, -1)


def fox_attention(q, k, v, logf):
    B, T, H, dh = q.shape
    scale = dh ** -0.5
    F = jnp.cumsum(logf.astype(jnp.float32), axis=1).transpose(0, 2, 1)
    outs = []
    for q0 in range(0, T, Q_BLOCK):
        q1 = q0 + Q_BLOCK
        s = jnp.einsum('bqhd,bkhd->bhqk', q[:, q0:q1], k[:, :q1]).astype(jnp.float32) * scale
        s = s + F[:, :, q0:q1, None] - F[:, :, None, :q1]
        causal = np.arange(q0, q1)[:, None] >= np.arange(q1)[None, :]
        p = jax.nn.softmax(jnp.where(causal, s, NEG), axis=-1).astype(v.dtype)
        outs.append(jnp.einsum('bhqk,bkhd->bqhd', p, v[:, :q1]))
    return jnp.concatenate(outs, axis=1)


def stick_breaking_attention(q, k, v):
    B, T, H, dh = q.shape
    scale = dh ** -0.5
    outs = []
    for q0 in range(0, T, Q_BLOCK):
        q1 = q0 + Q_BLOCK
        z = jnp.einsum('bqhd,bkhd->bhqk', q[:, q0:q1], k[:, :q1]).astype(jnp.float32) * scale
        strict = np.arange(q0, q1)[:, None] > np.arange(q1)[None, :]
        log_1mb = jnp.where(strict, jax.nn.log_sigmoid(-z), 0.0)
        later = lax.cumsum(log_1mb, axis=3, reverse=True) - log_1mb
        a = jnp.where(strict, jnp.exp(jax.nn.log_sigmoid(z) + later), 0.0).astype(v.dtype)
        outs.append(jnp.einsum('bhqk,bkhd->bqhd', a, v[:, :q1]))
    return jnp.concatenate(outs, axis=1)


def _compress(x, pe, w1, w2):
    T = x.shape[1]
    n_cmp = (T - CMP_BLOCK) // CMP_STRIDE + 1
    idx = np.arange(n_cmp)[:, None] * CMP_STRIDE + np.arange(CMP_BLOCK)[None, :]
    xb = x[:, idx] + pe[None, None, :, None, :]
    h = jax.nn.gelu(jnp.einsum('bclgd,lde->bcge', xb, w1))
    return jnp.einsum('bcge,ef->bgcf', h, w2)


def nsa_attention(q, k_cmp, v_cmp, k_slc, v_slc, k_win, v_win, gate_logits,
                  pe_k, w1_k, w2_k, pe_v, w1_v, w2_v, rel_bias):
    B, T, H, dh = q.shape
    G, R = NSA_KV_GROUPS, NSA_GQA
    scale = dh ** -0.5
    qg = q.reshape(B, T, G, R, dh).transpose(0, 2, 3, 1, 4)
    kc = _compress(k_cmp, pe_k, w1_k, w2_k)
    vc = _compress(v_cmp, pe_v, w1_v, w2_v)
    n_cmp = kc.shape[2]
    cmp_start = np.arange(n_cmp) * CMP_STRIDE
    cmp_end = cmp_start + CMP_BLOCK - 1
    n_slc = T // SLC_BLOCK
    n_top = min(SLC_TOPK, n_slc)
    slc_start = np.arange(n_slc) * SLC_BLOCK
    slc_end = slc_start + SLC_BLOCK - 1
    overlap = jnp.asarray(((cmp_start[:, None] <= slc_end[None, :]) &
                           (cmp_end[:, None] >= slc_start[None, :])).astype(np.float32))
    ks = k_slc.reshape(B, n_slc, SLC_BLOCK, G, dh).transpose(0, 3, 1, 2, 4)
    vs = v_slc.reshape(B, n_slc, SLC_BLOCK, G, dh).transpose(0, 3, 1, 2, 4)
    kw = jnp.pad(k_win.transpose(0, 2, 1, 3), ((0, 0), (0, 0), (WINDOW, 0), (0, 0)))
    vw = jnp.pad(v_win.transpose(0, 2, 1, 3), ((0, 0), (0, 0), (WINDOW, 0), (0, 0)))
    gates = jax.nn.sigmoid(gate_logits.astype(jnp.float32)).reshape(B, T, G, R, 3).transpose(0, 2, 3, 1, 4)
    tab = rel_bias.astype(jnp.float32).T.reshape(G, R, N_BUCKETS)
    wdist = np.arange(Q_BLOCK)[:, None] + WINDOW - np.arange(WINDOW + Q_BLOCK)[None, :]
    w_in_band = (wdist >= 0) & (wdist < WINDOW)
    wdist_j = jnp.asarray(wdist, dtype=jnp.int32)
    w_bias = tab[:, :, t5_bucket(wdist_j)]
    cmp_end_j = jnp.asarray(cmp_end, dtype=jnp.int32)
    blk = jnp.arange(n_slc, dtype=jnp.int32)
    b_ix = jnp.arange(B)[:, None, None, None]
    g_ix = jnp.arange(G)[None, :, None, None]
    g5 = jnp.arange(G)[None, :, None, None, None]
    r5 = jnp.arange(R)[None, None, :, None, None]

    def attend(q0):
        t = q0 + jnp.arange(Q_BLOCK, dtype=jnp.int32)
        qb = lax.dynamic_slice_in_dim(qg, q0, Q_BLOCK, axis=3)
        cdist = t[:, None] - cmp_end_j[None, :]
        cvalid = cdist >= 0
        sc = jnp.einsum('bgrqd,bgcd->bgrqc', qb, kc).astype(jnp.float32) * scale + tab[:, :, t5_bucket(cdist)]
        pc = jnp.where(cvalid, jax.nn.softmax(jnp.where(cvalid, sc, NEG), axis=-1), 0.0)
        o_cmp = jnp.einsum('bgrqc,bgcd->bgrqd', pc.astype(vc.dtype), vc)
        score = jnp.einsum('bgrqc,cn->bgqn', pc, overlap)
        cur = t // SLC_BLOCK
        forced = (blk[None, :] == 0) | (blk[None, :] == cur[:, None]) | (blk[None, :] == cur[:, None] - 1)
        future = blk[None, :] > cur[:, None]
        score = jnp.where(future, -1.0, jnp.where(forced, FORCED_SCORE, score))
        _, sel = lax.top_k(score, n_top)
        kg = ks[b_ix, g_ix, sel].reshape(B, G, Q_BLOCK, n_top * SLC_BLOCK, dh)
        vg = vs[b_ix, g_ix, sel].reshape(B, G, Q_BLOCK, n_top * SLC_BLOCK, dh)
        pos = (sel[..., None] * SLC_BLOCK + jnp.arange(SLC_BLOCK, dtype=jnp.int32)).reshape(B, G, Q_BLOCK, -1)
        sdist = t[None, None, :, None] - pos
        svalid = (sdist >= 0)[:, :, None]
        ss = (jnp.einsum('bgrqd,bgqkd->bgrqk', qb, kg).astype(jnp.float32) * scale
              + tab[g5, r5, t5_bucket(sdist)[:, :, None]])
        p_s = jax.nn.softmax(jnp.where(svalid, ss, NEG), axis=-1)
        o_slc = jnp.einsum('bgrqk,bgqkd->bgrqd', p_s.astype(vg.dtype), vg)
        kb = lax.dynamic_slice_in_dim(kw, q0, WINDOW + Q_BLOCK, axis=2)
        vb = lax.dynamic_slice_in_dim(vw, q0, WINDOW + Q_BLOCK, axis=2)
        wvalid = w_in_band & ((t[:, None] - wdist_j) >= 0)
        sw = jnp.einsum('bgrqd,bgkd->bgrqk', qb, kb).astype(jnp.float32) * scale + w_bias
        p_w = jax.nn.softmax(jnp.where(wvalid, sw, NEG), axis=-1)
        o_win = jnp.einsum('bgrqk,bgkd->bgrqd', p_w.astype(vb.dtype), vb)
        g = lax.dynamic_slice_in_dim(gates, q0, Q_BLOCK, axis=3)
        return (g[..., 0:1] * o_cmp + g[..., 1:2] * o_slc + g[..., 2:3] * o_win).astype(q.dtype)

    outs = lax.map(attend, jnp.arange(0, T, Q_BLOCK, dtype=jnp.int32))
    return outs.transpose(1, 0, 4, 2, 3, 5).reshape(B, T, H, dh)


def memory_cross_attention(h, mem_n, wq, wkv, wo):
    B, T, _ = h.shape
    q = _heads(h @ wq, XA_HEADS)
    k, v = jnp.split(mem_n @ wkv, 2, axis=-1)
    k, v = _heads(k, XA_HEADS), _heads(v, XA_HEADS)
    s = jnp.einsum('bthd,bmhd->bhtm', q, k).astype(jnp.float32) * (XA_HEAD_DIM ** -0.5)
    p = jax.nn.softmax(s, axis=-1).astype(v.dtype)
    o = jnp.einsum('bhtm,bmhd->bthd', p, v).reshape(B, T, XA_WIDTH)
    return o @ wo


def setup_inputs(seed: int = 0) -> dict:
    key = jax.random.key(seed)
    keys = iter(jax.random.split(key, 32))

    def nrm(shape, scale):
        return jax.random.normal(next(keys), shape, jnp.float32) * scale

    def gain(shape):
        return 1.0 + nrm(shape, 0.05)

    ne = (DEPTH + 1) // 2
    no = DEPTH // 2
    d = D_MODEL
    return {
        'x': nrm((BATCH, SEQ, d), 1.0),
        'mem': nrm((BATCH, MEM_LEN, d), 1.0),
        'rel_bias': nrm((N_BUCKETS, NSA_HEADS), 0.2),
        'mem_norm_g': gain((d,)),
        'norm_mix_g': gain((DEPTH, d)),
        'norm_xattn_g': gain((DEPTH, d)),
        'norm_mlp_g': gain((DEPTH, d)),
        'final_norm_g': gain((d,)),
        'w_in_even': nrm((ne, d, EVEN_PROJ), d ** -0.5),
        'b_forget': FORGET_BIAS_INIT + nrm((ne, FOX_HEADS), 0.5),
        'cmp_pe_k': nrm((ne, CMP_BLOCK, HEAD_DIM), 0.02),
        'cmp_w1_k': nrm((ne, CMP_BLOCK, HEAD_DIM, HEAD_DIM), (CMP_BLOCK * HEAD_DIM) ** -0.5),
        'cmp_w2_k': nrm((ne, HEAD_DIM, HEAD_DIM), HEAD_DIM ** -0.5),
        'cmp_pe_v': nrm((ne, CMP_BLOCK, HEAD_DIM), 0.02),
        'cmp_w1_v': nrm((ne, CMP_BLOCK, HEAD_DIM, HEAD_DIM), (CMP_BLOCK * HEAD_DIM) ** -0.5),
        'cmp_w2_v': nrm((ne, HEAD_DIM, HEAD_DIM), HEAD_DIM ** -0.5),
        'w_out_even': nrm((ne, FOX_W + NSA_W, d), (FOX_W + NSA_W) ** -0.5),
        'w_in_odd': nrm((no, d, ODD_PROJ), d ** -0.5),
        'w_out_odd': nrm((no, SB_HEADS * HEAD_DIM, d), (SB_HEADS * HEAD_DIM) ** -0.5),
        'xa_wq': nrm((DEPTH, d, XA_WIDTH), d ** -0.5),
        'xa_wkv': nrm((DEPTH, d, 2 * XA_WIDTH), d ** -0.5),
        'xa_wo': nrm((DEPTH, XA_WIDTH, d), XA_WIDTH ** -0.5),
        'mlp_w1': nrm((DEPTH, d, D_FF), d ** -0.5),
        'mlp_w2': nrm((DEPTH, D_FF, d), D_FF ** -0.5),
    }


def reference(x, mem, rel_bias, mem_norm_g, norm_mix_g, norm_xattn_g, norm_mlp_g, final_norm_g,
              w_in_even, b_forget, cmp_pe_k, cmp_w1_k, cmp_w2_k, cmp_pe_v, cmp_w1_v, cmp_w2_v,
              w_out_even, w_in_odd, w_out_odd, xa_wq, xa_wkv, xa_wo, mlp_w1, mlp_w2):
    B, T, _ = x.shape
    mem_n = rmsnorm(mem, mem_norm_g)
    for layer in range(DEPTH):
        h = rmsnorm(x, norm_mix_g[layer])
        if layer % 2 == 0:
            e = layer // 2
            (fq, fk, fv, ff, nq, kc, vc, ksl, vsl, kwn, vwn, ng) = jnp.split(h @ w_in_even[e], EVEN_OFFSETS, axis=-1)
            logf = jax.nn.log_sigmoid(ff.astype(jnp.float32) + b_forget[e].astype(jnp.float32))
            fox = fox_attention(_heads(fq, FOX_HEADS), _heads(fk, FOX_HEADS), _heads(fv, FOX_HEADS), logf)
            nsa = nsa_attention(_heads(nq, NSA_HEADS),
                                _heads(kc, NSA_KV_GROUPS), _heads(vc, NSA_KV_GROUPS),
                                _heads(ksl, NSA_KV_GROUPS), _heads(vsl, NSA_KV_GROUPS),
                                _heads(kwn, NSA_KV_GROUPS), _heads(vwn, NSA_KV_GROUPS), ng,
                                cmp_pe_k[e], cmp_w1_k[e], cmp_w2_k[e],
                                cmp_pe_v[e], cmp_w1_v[e], cmp_w2_v[e], rel_bias)
            mixed = jnp.concatenate([fox.reshape(B, T, FOX_W), nsa.reshape(B, T, NSA_W)], axis=-1) @ w_out_even[e]
        else:
            o = layer // 2
            sq, sk, sv = jnp.split(h @ w_in_odd[o], 3, axis=-1)
            sb = stick_breaking_attention(_heads(sq, SB_HEADS), _heads(sk, SB_HEADS), _heads(sv, SB_HEADS))
            mixed = sb.reshape(B, T, SB_HEADS * HEAD_DIM) @ w_out_odd[o]
        x = x + mixed
        x = x + memory_cross_attention(rmsnorm(x, norm_xattn_g[layer]), mem_n,
                                       xa_wq[layer], xa_wkv[layer], xa_wo[layer])
        hm = rmsnorm(x, norm_mlp_g[layer])
        x = x + jnp.square(jax.nn.relu(hm @ mlp_w1[layer])) @ mlp_w2[layer]
    return rmsnorm(x, final_norm_g)
```

```cpp
#include <hip/hip_runtime.h>
#include <cstdio>
#include <cstdint>
#include <cmath>

namespace pg8 {
#define PG8_LAS __attribute__((address_space(3)))
typedef unsigned short bf16_t;
typedef short bf16x8 __attribute__((ext_vector_type(8)));
typedef float f32x4 __attribute__((ext_vector_type(4)));
typedef unsigned u32x4 __attribute__((ext_vector_type(4)));
constexpr int BM = 256, BK = 64, HALF = 128, HTB = HALF * BK * 2  , STAGE_BYTES = 8 * HTB, NXCD = 8, WGM = 8;

__host__ __device__ __forceinline__ int lds_byte(int r, int c) { const int st = (r >> 4) * 2 + (c >> 5), rr = r & 15, cc = c & 31, ob = rr * 64 + cc * 2; return st * 1024 + (ob ^ (((ob >> 9) & 1) << 5)); }
__host__ __device__ __forceinline__ void stage_rc(int b, int& R, int& C) { const int st = b / 1024, sb = b % 1024, swz = sb ^ (((sb >> 9) & 1) << 5); R = (st >> 1) * 16 + swz / 64; C = (st & 1) * 32 + (swz % 64) / 2; }
__host__ __device__ __forceinline__ int perm32(int rho) { const int n = rho >> 4, i = rho & 15; return 8 * (i >> 2) + 4 * n + (i & 3); }

struct Unit { int pm, pn; };
struct Gemm { const bf16_t* A; const bf16_t* Bt; int M, N, K; };

struct StaticOrder {
    int nM, nN, nwg, G, c;
    __host__ __device__ void init(int M, int N, int G_, int c_) { nM = M / BM; nN = N / BM; nwg = nM * nN; G = G_; c = c_; }
    __host__ __device__ bool next(int i, Unit& u) const {
        const long L = (long)i * G + c; if (L >= nwg) return false;
        int wgid = (int)L; { const int q = nwg / NXCD, r = nwg % NXCD, xcd = wgid % NXCD, off = wgid / NXCD; wgid = (xcd < r ? xcd * (q + 1) : r * (q + 1) + (xcd - r) * q) + off; }
        const int nig = WGM * nN, gid = wgid / nig, fm = gid * WGM, gsz = (nM - fm) < WGM ? (nM - fm) : WGM;
        u.pm = fm + ((wgid % nig) % gsz); u.pn = (wgid % nig) / gsz; return true;
    }
    __device__ __forceinline__ void a_ready(const Unit&) const {}
    __device__ __forceinline__ void done(const Unit&) const {}
};
__device__ __forceinline__ unsigned cvt_pk_bf16(float lo, float hi) { unsigned r; asm volatile("v_cvt_pk_bf16_f32 %0, %1, %2" : "=v"(r) : "v"(lo), "v"(hi)); return r; }
typedef float f32x2 __attribute__((ext_vector_type(2)));
constexpr float RMS_EPS = 1e-6f, LOG2E_F = 1.4426950408889634f;
__device__ __forceinline__ float row_rs(const float* ss, int row) {
    const f32x4* p = (const f32x4*)(ss + (size_t)row * 16);
    const f32x4 a = p[0], b = p[1], c = p[2], d = p[3];
    const float s = ((a[0] + a[1]) + (a[2] + a[3])) + ((b[0] + b[1]) + (b[2] + b[3])) + ((c[0] + c[1]) + (c[2] + c[3])) + ((d[0] + d[1]) + (d[2] + d[3]));
    return 1.0f / sqrtf(s * (1.0f / 1024.0f) + RMS_EPS);
}
template <int ACT, bool SPECIAL> struct EpiBf {
    static constexpr bool PERM = true, AFTER_DRAIN = false;
    bf16_t* O; int ldc; const float* ss; float* LF; float* GT; const float* bforget;
    __device__ __forceinline__ void operator()(const f32x4 (&acc)[2][2][4][2], const Unit& u, int wr, int wc, int fr, int fq) const {
        const int row0 = u.pm * BM + wr * 64 + fr;
        if (SPECIAL && u.pn == 11) {
            if (wc != 0) return;
#pragma unroll
            for (int ai = 0; ai < 2; ++ai)
#pragma unroll
                for (int m = 0; m < 4; ++m) {
                    const int row = row0 + ai * HALF + m * 16; const float r = row_rs(ss, row);
                    const f32x4 v0 = acc[ai][0][m][0] * r, v1 = acc[ai][0][m][1] * r;
                    const float v[8] = {v0[0], v0[1], v0[2], v0[3], v1[0], v1[1], v1[2], v1[3]};
                    if (fq == 0) { const int b = row >> 11, t = row & 2047;
#pragma unroll
                        for (int j = 0; j < 8; ++j) { const float x = v[j] + bforget[j]; const float lf = fminf(x, 0.f) - log1pf(expf(-fabsf(x))); LF[(size_t)(b * 8 + j) * 2048 + t] = lf * LOG2E_F; }
                    } else {
#pragma unroll
                        for (int j = 0; j < 8; ++j) GT[(size_t)row * 24 + 8 * (fq - 1) + j] = 1.0f / (1.0f + expf(-v[j]));
                    }
                }
            return;
        }
        const int col0 = u.pn * BM + wc * 32 + 8 * fq;
#pragma unroll
        for (int ai = 0; ai < 2; ++ai)
#pragma unroll
            for (int m = 0; m < 4; ++m) { const int row = row0 + ai * HALF + m * 16; const float r = ss ? row_rs(ss, row) : 1.0f; bf16_t* rowp = O + (size_t)row * ldc + col0;
#pragma unroll
                for (int bj = 0; bj < 2; ++bj) { f32x4 v0 = acc[ai][bj][m][0] * r, v1 = acc[ai][bj][m][1] * r;
                    if (ACT == 1) {
#pragma unroll
                        for (int i = 0; i < 4; ++i) { const float a = fmaxf(v0[i], 0.f), b = fmaxf(v1[i], 0.f); v0[i] = a * a; v1[i] = b * b; } }
                    u32x4 w; w.x = cvt_pk_bf16(v0[0], v0[1]); w.y = cvt_pk_bf16(v0[2], v0[3]); w.z = cvt_pk_bf16(v1[0], v1[1]); w.w = cvt_pk_bf16(v1[2], v1[3]);
                    *(u32x4*)(rowp + bj * HALF) = w; } }
    }
};
struct EpiResid {
    static constexpr bool PERM = false, AFTER_DRAIN = false;
    float* X; bf16_t* XB; float* SS;
    __device__ __forceinline__ void operator()(const f32x4 (&acc)[2][2][4][2], const Unit& u, int wr, int wc, int fr, int fq) const {
        typedef unsigned u32x2v __attribute__((ext_vector_type(2)));
        const int row0 = u.pm * BM + wr * 64 + fr, col0 = u.pn * BM + wc * 32 + 4 * fq;
#pragma unroll
        for (int ai = 0; ai < 2; ++ai)
#pragma unroll
            for (int m = 0; m < 4; ++m) { const int row = row0 + ai * HALF + m * 16; const size_t off = (size_t)row * 1024 + col0; float sq = 0.f;
#pragma unroll
                for (int bj = 0; bj < 2; ++bj)
#pragma unroll
                    for (int n = 0; n < 2; ++n) { float* xp = X + off + bj * HALF + n * 16; f32x4 xv = *(const f32x4*)xp; xv = xv + acc[ai][bj][m][n]; *(f32x4*)xp = xv;
                        sq += (xv[0] * xv[0] + xv[1] * xv[1]) + (xv[2] * xv[2] + xv[3] * xv[3]);
                        u32x2v w; w.x = cvt_pk_bf16(xv[0], xv[1]); w.y = cvt_pk_bf16(xv[2], xv[3]); *(u32x2v*)(XB + off + bj * HALF + n * 16) = w; }
                sq += __shfl_xor(sq, 16); sq += __shfl_xor(sq, 32);
                if (fq == 0) SS[(size_t)row * 16 + u.pn * 4 + wc] = sq; }
    }
};


template <class Epi, class Sched, bool ALIGN_EPI = false, bool SP2 = false>
__device__ __forceinline__ void gemm_phase(PG8_LAS unsigned char* lds, const Gemm g, const Sched& S, const Epi& E) {
    const int tid = threadIdx.x, wid = __builtin_amdgcn_readfirstlane(tid >> 6), lane = tid & 63, wr = wid >> 2, wc = wid & 3, fr = lane & 15, fq = lane >> 4;
    const int K = g.K, nt = K / BK;
    unsigned voffA[2], voffB[2];
#pragma unroll
    for (int i = 0; i < 2; ++i) { int R, C; stage_rc(tid * 16 + i * 8192, R, C); const int Rb = Epi::PERM ? ((R & ~31) + perm32(R & 31)) : R;
        voffA[i] = (unsigned)(R * K + C) * 2u; voffB[i] = (unsigned)(Rb * K + C) * 2u; }
    const size_t kstep = (size_t)(BK * 2);
    const size_t hstep = (size_t)HALF * K * 2;
    const size_t tstep = 2 * hstep;
    const unsigned ldsw = (unsigned)wid * 1024u;
    const int aoff = lds_byte(wr * 64 + fr, fq * 8), boff = lds_byte(wc * 32 + fr, fq * 8);
#define PG8_SA(b, h) (((b) * 2 + (h)) * HTB)
#define PG8_SB(b, h) ((4 + (b) * 2 + (h)) * HTB)
#define PG8_STAGE(bufoff, gbase, voff) do { _Pragma("unroll") for (int _i = 0; _i < 2; ++_i) \
        __builtin_amdgcn_global_load_lds((const unsigned*)((const char*)(gbase) + (voff)[_i]), (PG8_LAS unsigned*)(lds + (bufoff) + ldsw + _i * 8192), 16, 0, 0); } while (0)
#define PG8_LDA(dst, b, h) do { _Pragma("unroll") for (int m = 0; m < 4; ++m) _Pragma("unroll") for (int k = 0; k < 2; ++k) dst[m][k] = *(const PG8_LAS bf16x8*)(lds + PG8_SA(b, h) + aoff + m * 2048 + k * 1024); } while (0)
#define PG8_LDB(dst, b, h) do { _Pragma("unroll") for (int n = 0; n < 2; ++n) _Pragma("unroll") for (int k = 0; k < 2; ++k) dst[n][k] = *(const PG8_LAS bf16x8*)(lds + PG8_SB(b, h) + boff + n * 2048 + k * 1024); } while (0)
#define PG8_MMA(ai, bj, At, Bt) do { __builtin_amdgcn_s_setprio(1); _Pragma("unroll") for (int m = 0; m < 4; ++m) _Pragma("unroll") for (int n = 0; n < 2; ++n) _Pragma("unroll") for (int k = 0; k < 2; ++k) \
        acc[ai][bj][m][n] = __builtin_amdgcn_mfma_f32_16x16x32_bf16(Bt[n][k], At[m][k], acc[ai][bj][m][n], 0, 0, 0); __builtin_amdgcn_s_setprio(0); } while (0)
#define PG8_WAIT_V(n) asm volatile("s_waitcnt vmcnt(" #n ")" ::: "memory")
#define PG8_WAIT_L(n) asm volatile("s_waitcnt lgkmcnt(" #n ")" ::: "memory")
#define PG8_BAR __builtin_amdgcn_s_barrier()
#define PG8_SCHED __builtin_amdgcn_sched_barrier(0)
    Unit cur, nxt; int ui = 0;
    if (!S.next(0, cur)) return;
    f32x4 acc[2][2][4][2];
#pragma unroll
    for (int a = 0; a < 2; ++a)
#pragma unroll
        for (int b = 0; b < 2; ++b)
#pragma unroll
            for (int m = 0; m < 4; ++m)
#pragma unroll
                for (int n = 0; n < 2; ++n) acc[a][b][m][n] = (f32x4){0.f, 0.f, 0.f, 0.f};
    bf16x8 At[4][2], B0[2][2], B1[2][2];
    const char* cA = (const char*)g.A + (size_t)cur.pm * tstep; const char* cB = (const char*)g.Bt + (size_t)cur.pn * tstep;
    S.a_ready(cur);
    if constexpr (SP2) {
        PG8_STAGE(PG8_SB(0, 0), cB, voffB); PG8_STAGE(PG8_SB(0, 1), cB + hstep, voffB); PG8_STAGE(PG8_SA(0, 0), cA, voffA); PG8_STAGE(PG8_SA(0, 1), cA + hstep, voffA);
        if (wr == 1) PG8_BAR;
        PG8_WAIT_V(2); PG8_BAR;
        PG8_STAGE(PG8_SB(1, 0), cB + kstep, voffB); PG8_STAGE(PG8_SA(1, 0), cA + kstep, voffA); PG8_STAGE(PG8_SB(1, 1), cB + hstep + kstep, voffB);
        PG8_WAIT_V(6); PG8_BAR;
    } else {
        PG8_STAGE(PG8_SB(0, 0), cB, voffB); PG8_STAGE(PG8_SA(0, 0), cA, voffA); PG8_STAGE(PG8_SB(0, 1), cB + hstep, voffB); PG8_STAGE(PG8_SA(0, 1), cA + hstep, voffA);
        if (wr == 1) PG8_BAR;
        PG8_WAIT_V(4); PG8_BAR;
        PG8_STAGE(PG8_SB(1, 0), cB + kstep, voffB); PG8_STAGE(PG8_SA(1, 0), cA + kstep, voffA); PG8_STAGE(PG8_SB(1, 1), cB + hstep + kstep, voffB);
        PG8_WAIT_V(6); PG8_BAR;
    }
    for (;;) {
        const bool has_next = S.next(ui + 1, nxt);
        const char* nA = has_next ? (const char*)g.A + (size_t)nxt.pm * tstep : cA; const char* nB = has_next ? (const char*)g.Bt + (size_t)nxt.pn * tstep : cB;
        for (int t = 0; t < nt; t += 2) {
            const bool last = (t == nt - 2);
            const char* a1 = cA + (size_t)(t + 1) * kstep;
            const char* a2 = last ? nA : cA + (size_t)(t + 2) * kstep; const char* b2 = last ? nB : cB + (size_t)(t + 2) * kstep;
            const char* a3 = a2 + kstep; const char* b3 = b2 + kstep;
            if (last && has_next) S.a_ready(nxt);
            if constexpr (SP2) {
            PG8_LDB(B0, 0, 0); PG8_LDB(B1, 0, 1); PG8_SCHED; PG8_LDA(At, 0, 0); PG8_STAGE(PG8_SA(1, 1), a1 + hstep, voffA);
            PG8_WAIT_V(8); PG8_WAIT_L(0); PG8_BAR; PG8_MMA(0, 0, At, B0); PG8_MMA(0, 1, At, B1); PG8_BAR; PG8_SCHED;
            PG8_LDA(At, 0, 1); PG8_STAGE(PG8_SB(0, 0), b2, voffB); PG8_STAGE(PG8_SB(0, 1), b2 + hstep, voffB); PG8_STAGE(PG8_SA(0, 0), a2, voffA);
            PG8_WAIT_V(8); PG8_WAIT_L(0); PG8_BAR; PG8_MMA(1, 0, At, B0); PG8_MMA(1, 1, At, B1); PG8_BAR; PG8_SCHED;
            PG8_LDB(B0, 1, 0); PG8_LDB(B1, 1, 1); PG8_SCHED; PG8_LDA(At, 1, 0); PG8_STAGE(PG8_SA(0, 1), a2 + hstep, voffA);
            PG8_WAIT_V(8); PG8_WAIT_L(0); PG8_BAR; PG8_MMA(0, 0, At, B0); PG8_MMA(0, 1, At, B1); PG8_BAR; PG8_SCHED;
            PG8_LDA(At, 1, 1); PG8_STAGE(PG8_SB(1, 0), b3, voffB); PG8_STAGE(PG8_SB(1, 1), b3 + hstep, voffB); PG8_STAGE(PG8_SA(1, 0), a3, voffA);
            PG8_WAIT_V(8); PG8_WAIT_L(0); PG8_BAR; PG8_MMA(1, 0, At, B0); PG8_MMA(1, 1, At, B1); PG8_BAR; PG8_SCHED;
            } else {
            PG8_LDB(B0, 0, 0); PG8_SCHED; PG8_LDA(At, 0, 0); PG8_STAGE(PG8_SA(1, 1), a1 + hstep, voffA);
            PG8_WAIT_L(8); PG8_BAR; PG8_WAIT_L(0); PG8_MMA(0, 0, At, B0); PG8_BAR; PG8_SCHED;
            PG8_LDB(B1, 0, 1); PG8_STAGE(PG8_SB(0, 0), b2, voffB);
            PG8_BAR; PG8_WAIT_L(0); PG8_MMA(0, 1, At, B1); PG8_BAR;
            PG8_LDA(At, 0, 1); PG8_STAGE(PG8_SA(0, 0), a2, voffA);
            PG8_BAR; PG8_WAIT_L(0); PG8_MMA(1, 0, At, B0); PG8_BAR; PG8_SCHED;
            PG8_STAGE(PG8_SB(0, 1), b2 + hstep, voffB);
            PG8_WAIT_V(6); PG8_BAR; PG8_MMA(1, 1, At, B1); PG8_BAR;
            PG8_LDB(B0, 1, 0); PG8_SCHED; PG8_LDA(At, 1, 0); PG8_STAGE(PG8_SA(0, 1), a2 + hstep, voffA);
            PG8_WAIT_L(8); PG8_BAR; PG8_WAIT_L(0); PG8_MMA(0, 0, At, B0); PG8_BAR; PG8_SCHED;
            PG8_LDB(B1, 1, 1); PG8_STAGE(PG8_SB(1, 0), b3, voffB);
            PG8_BAR; PG8_WAIT_L(0); PG8_MMA(0, 1, At, B1); PG8_BAR;
            PG8_LDA(At, 1, 1); PG8_STAGE(PG8_SA(1, 0), a3, voffA);
            PG8_BAR; PG8_WAIT_L(0); PG8_MMA(1, 0, At, B0); PG8_BAR; PG8_SCHED;
            PG8_STAGE(PG8_SB(1, 1), b3 + hstep, voffB);
            PG8_WAIT_V(6); PG8_BAR; PG8_MMA(1, 1, At, B1); PG8_BAR;
            }
        }
        if constexpr (ALIGN_EPI) { if (wr == 0) PG8_BAR; }
        if constexpr (!Epi::AFTER_DRAIN) { E(acc, cur, wr, wc, fr, fq); S.done(cur); }
        if (!has_next) break;
#pragma unroll
        for (int a = 0; a < 2; ++a)
#pragma unroll
            for (int b = 0; b < 2; ++b)
#pragma unroll
                for (int m = 0; m < 4; ++m)
#pragma unroll
                    for (int n = 0; n < 2; ++n) acc[a][b][m][n] = (f32x4){0.f, 0.f, 0.f, 0.f};
        cur = nxt; cA = nA; cB = nB; ++ui;
        if constexpr (ALIGN_EPI) { if (wr == 1) PG8_BAR; }
    }
    PG8_WAIT_V(0);
    if constexpr (!ALIGN_EPI) { if (wr == 0) PG8_BAR; }
    PG8_BAR;
    if constexpr (Epi::AFTER_DRAIN) { E.fused(acc, cur, wr, wc, fr, fq, lds, wid, lane); S.done(cur); }
#undef PG8_SA
#undef PG8_SB
#undef PG8_STAGE
#undef PG8_LDA
#undef PG8_LDB
#undef PG8_MMA
#undef PG8_WAIT_V
#undef PG8_WAIT_L
#undef PG8_BAR
#undef PG8_SCHED
}
}
#define GAS __attribute__((address_space(1)))
#define LAS __attribute__((address_space(3)))
typedef unsigned short bf16;
typedef unsigned v4u __attribute__((ext_vector_type(4)));
typedef float f32x4 __attribute__((ext_vector_type(4)));
typedef short bf16x8 __attribute__((ext_vector_type(8)));
typedef GAS unsigned gu32;
typedef GAS unsigned long long gu64;
#define RLX_AGENT __ATOMIC_RELAXED, __HIP_MEMORY_SCOPE_AGENT
#define LDS_WAIT() asm volatile("s_waitcnt lgkmcnt(0)" ::: "memory")
#define VM_WAIT() asm volatile("s_waitcnt vmcnt(0)" ::: "memory")
__device__ __forceinline__ unsigned long long rt() { return __builtin_amdgcn_s_memrealtime(); }
__device__ __forceinline__ unsigned f2bf(float f) { unsigned u = __builtin_bit_cast(unsigned, f); return (u + 0x7fffu + ((u >> 16) & 1u)) >> 16; }
__device__ __forceinline__ unsigned pk2(float lo, float hi) { return f2bf(lo) | (f2bf(hi) << 16); }
#define XB_TMO      128
#define XB_XCNT(j)  (256  + 64 * (j))
#define XB_XSUB(j)  (1280 + 64 * (j))
#define XB_XGEN(j)  (2304 + 64 * (j))
#define XB_TOP      3328
#define XB_TOPGEN   3392
#define XCD_BAR_WORDS 3456
#define XB_SPIN_CAP (1u << 18)

__device__ __forceinline__ unsigned xb_ld(unsigned* p)              { return __hip_atomic_load(p, __ATOMIC_RELAXED, __HIP_MEMORY_SCOPE_AGENT); }
__device__ __forceinline__ unsigned xb_add(unsigned* p, unsigned v) { return __hip_atomic_fetch_add(p, v, __ATOMIC_RELAXED, __HIP_MEMORY_SCOPE_AGENT); }
__device__ __forceinline__ unsigned xb_xcc_id() { return (unsigned)__builtin_amdgcn_s_getreg((3 << 11) | 20) & 0xFu; }
#define XB_SPIN(cond, bar) do { unsigned _sp = 0; while (cond) { __builtin_amdgcn_s_sleep(1); \
    if ((++_sp & 255u) == 0u) { if (xb_ld(&(bar)[XB_TMO])) break; if (_sp > XB_SPIN_CAP) { atomicAdd(&(bar)[XB_TMO], 1u); break; } } } } while (0)

struct XcdBarrier {
    unsigned* bar; unsigned x;
    volatile LAS unsigned* st;
};

__device__ __forceinline__ XcdBarrier xcd_barrier_post(unsigned* bar, volatile LAS unsigned* st) {
    XcdBarrier b; b.bar = bar; b.x = xb_xcc_id(); b.st = st;
    if (threadIdx.x == 0) (void)xb_add(&bar[XB_XCNT(b.x)], 1u);
    return b;
}
__device__ __forceinline__ void xcd_barrier_complete(unsigned* bar, unsigned x, unsigned& nloc, unsigned& nx) {
    const unsigned G = gridDim.x * gridDim.y * gridDim.z;
    unsigned sum, cnt, mine, sp = 0u;
    for (;;) {
        sum = 0u; cnt = 0u; mine = 0u;
#pragma unroll
        for (unsigned j = 0; j < 16; ++j) { const unsigned c = xb_ld(&bar[XB_XCNT(j)]); sum += c; cnt += (c > 0u) ? 1u : 0u; mine = (j == x) ? c : mine; }
        if (sum == G) break;
        __builtin_amdgcn_s_sleep(1);
        if ((++sp & 255u) == 0u) { if (xb_ld(&bar[XB_TMO])) break; if (sp > XB_SPIN_CAP) { atomicAdd(&bar[XB_TMO], 1u); break; } }
    }
    nloc = mine > 0u ? mine : 1u; nx = cnt > 0u ? cnt : 1u;
}

__device__ __forceinline__ void xcd_barrier(const XcdBarrier& b) {
    asm volatile("s_waitcnt vmcnt(0)" ::: "memory");
    __syncthreads();
    if (threadIdx.x == 0) {
        unsigned* bar = b.bar;
        __builtin_amdgcn_s_waitcnt(0);
        unsigned nloc = b.st[0], nx = b.st[1];
        if (nloc == 0u) { xcd_barrier_complete(bar, b.x, nloc, nx); b.st[0] = nloc; b.st[1] = nx; }
        const unsigned old = xb_add(&bar[XB_XSUB(b.x)], 1u);
        const unsigned gen = old / nloc;
        if (old + 1u == (gen + 1u) * nloc) {
            __builtin_amdgcn_fence(__ATOMIC_RELEASE, "agent");
            asm volatile("s_waitcnt vmcnt(0)" ::: "memory");
            const unsigned og = xb_add(&bar[XB_TOP], 1u);
            const unsigned tg = og / nx;
            if (og + 1u == (tg + 1u) * nx) xb_add(&bar[XB_TOPGEN], 1u);
            else XB_SPIN(xb_ld(&bar[XB_TOPGEN]) == tg, bar);
            __builtin_amdgcn_fence(__ATOMIC_ACQUIRE, "agent");
            xb_add(&bar[XB_XGEN(b.x)], 1u);
            asm volatile("s_waitcnt vmcnt(0)" ::: "memory");
        } else {
            XB_SPIN(xb_ld(&bar[XB_XGEN(b.x)]) == gen, bar);
            __builtin_amdgcn_fence(__ATOMIC_ACQUIRE, "agent");
            asm volatile("s_waitcnt vmcnt(0)" ::: "memory");
        }
    }
    __syncthreads();
}
constexpr int NB_ = 8, T_ = 2048, D_ = 1024, M_ = NB_ * T_, DEPTH_ = 4, MEMLEN_ = 256, MM_ = NB_ * MEMLEN_, FF_ = 4096;
constexpr int NPROJ = 3072;
constexpr float LOG2E = 1.4426950408889634f, EPS_ = 1e-6f;
constexpr float C2_64 = 0.125f * LOG2E;
constexpr float C2_128 = 0.08838834764831845f * LOG2E;
constexpr int EC_FQ = 0, EC_FK = 512, EC_FV = 1024, EC_NQ = 1536, EC_KC = 2048, EC_VC = 2176, EC_KSL = 2304, EC_VSL = 2432, EC_KWN = 2560, EC_VWN = 2688, EC_FF = 2816, EC_NG = 2824, EC_END = 2848;
constexpr int OC_SQ = 0, OC_SK = 1024, OC_SV = 2048;

constexpr size_t MiB = 1u << 20;
constexpr size_t WS_CTL = 0, CTL_ZERO_BYTES = 64 * 1024;
constexpr size_t WS_SS = 1 * MiB;
constexpr size_t WS_LF = 2 * MiB;
constexpr size_t WS_GT = 3 * MiB;
constexpr size_t WS_KC = 5 * MiB, WS_VC = 6 * MiB;
constexpr size_t WS_MEMN = 7 * MiB;
constexpr size_t WS_MEMKV = 11 * MiB;
constexpr size_t WS_WIN = 16 * MiB, WS_WOUT = 40 * MiB, WS_WQ = 48 * MiB, WS_WKV = 52 * MiB, WS_WO = 60 * MiB, WS_W1 = 64 * MiB, WS_W2 = 96 * MiB;
constexpr size_t WS_XB = 128 * MiB;
constexpr size_t WS_ARENA = 160 * MiB;
constexpr size_t WS_PROJ = WS_ARENA, WS_AO = WS_ARENA + 96 * MiB, WS_QX = WS_ARENA, WS_AOX = WS_ARENA + 16 * MiB, WS_H = WS_ARENA;
constexpr size_t WS_END = 288 * MiB;
constexpr int CW_BAR = 4096;
static_assert((CW_BAR + XCD_BAR_WORDS) * 4 <= (int)CTL_ZERO_BYTES, "ctl");

constexpr int RING_OFF = 0, RING_BYTES = 131072;
constexpr int LDSCTL_OFF = RING_BYTES, MISC_OFF = LDSCTL_OFF + 320;
constexpr int LDS_BYTES = 147456;
constexpr int NWAVES = 8, NTHR = 512;

__device__ const unsigned char T5_BUCKET[128] = {0, 1, 2, 3, 4, 5, 6, 7, 8, 9, 10, 11, 12, 13, 14, 15, 16, 16, 16, 17, 17, 18, 18, 18, 19, 19, 19, 20, 20, 20, 20, 21, 21, 21, 21, 22, 22, 22, 22, 22, 23, 23, 23, 23, 23, 23, 24, 24, 24, 24, 24, 24, 25, 25, 25, 25, 25, 25, 25, 26, 26, 26, 26, 26, 26, 26, 26, 27, 27, 27, 27, 27, 27, 27, 27, 27, 27, 28, 28, 28, 28, 28, 28, 28, 28, 28, 28, 29, 29, 29, 29, 29, 29, 29, 29, 29, 29, 29, 29, 30, 30, 30, 30, 30, 30, 30, 30, 30, 30, 30, 30, 30, 30, 31, 31, 31, 31, 31, 31, 31, 31, 31, 31, 31, 31, 31, 31, 31};

struct Args {
    const float *x, *mem, *rel_bias, *mem_norm_g, *norm_mix_g, *norm_xattn_g, *norm_mlp_g, *final_norm_g, *w_in_even, *b_forget, *cmp_pe_k, *cmp_w1_k, *cmp_w2_k, *cmp_pe_v, *cmp_w1_v, *cmp_w2_v,
        *w_out_even, *w_in_odd, *w_out_odd, *xa_wq, *xa_wkv, *xa_wo, *mlp_w1, *mlp_w2;
    float* out; unsigned char* ws; int ph_lo, ph_hi;
};
struct Frame {
    LAS unsigned char* lds; int tid, lane, wave, G, vcu;
    unsigned char* ws;
};
__device__ __forceinline__ float bf2f(unsigned short v) { return __uint_as_float((unsigned)v << 16); }
__device__ __forceinline__ float wave_sum(float v) {
#pragma unroll
    for (int o = 1; o < 64; o <<= 1) v += __shfl_xor(v, o);
    return v;
}
__device__ __forceinline__ void ld8(const bf16* p, float* o) {
    const v4u w = *(const v4u*)p;
    o[0] = __uint_as_float(w.x << 16); o[1] = __uint_as_float(w.x & 0xffff0000u); o[2] = __uint_as_float(w.y << 16); o[3] = __uint_as_float(w.y & 0xffff0000u);
    o[4] = __uint_as_float(w.z << 16); o[5] = __uint_as_float(w.z & 0xffff0000u); o[6] = __uint_as_float(w.w << 16); o[7] = __uint_as_float(w.w & 0xffff0000u);
}

__device__ __forceinline__ void p0_weight_item(const Frame& F, const Args& a, int layer, int kind, int item, LAS float* scr) {
    const int lane = F.lane; const bool even = (layer & 1) == 0; const int e2 = layer >> 1;
    const float* W; const float* gain = nullptr; int K, Nsrc, Ndst; bf16* dst;
    switch (kind) {
        case 0: K = 1024; Ndst = NPROJ; gain = a.norm_mix_g + layer * 1024; dst = (bf16*)(F.ws + WS_WIN) + (size_t)layer * NPROJ * 1024;
                if (even) { W = a.w_in_even + (size_t)e2 * 1024 * 2848; Nsrc = 2848; } else { W = a.w_in_odd + (size_t)e2 * 1024 * 3072; Nsrc = 3072; } break;
        case 1: K = 1024; Ndst = 1024; Nsrc = 1024; W = (even ? a.w_out_even : a.w_out_odd) + (size_t)e2 * 1024 * 1024; dst = (bf16*)(F.ws + WS_WOUT) + (size_t)layer * 1024 * 1024; break;
        case 2: K = 1024; Ndst = 512; Nsrc = 512; W = a.xa_wq + (size_t)layer * 1024 * 512; gain = a.norm_xattn_g + layer * 1024; dst = (bf16*)(F.ws + WS_WQ) + (size_t)layer * 512 * 1024; break;
        case 3: K = 1024; Ndst = 1024; Nsrc = 1024; W = a.xa_wkv + (size_t)layer * 1024 * 1024; dst = (bf16*)(F.ws + WS_WKV) + (size_t)layer * 1024 * 1024; break;
        case 4: K = 512; Ndst = 1024; Nsrc = 1024; W = a.xa_wo + (size_t)layer * 512 * 1024; dst = (bf16*)(F.ws + WS_WO) + (size_t)layer * 1024 * 512; break;
        case 5: K = 1024; Ndst = 4096; Nsrc = 4096; W = a.mlp_w1 + (size_t)layer * 1024 * 4096; gain = a.norm_mlp_g + layer * 1024; dst = (bf16*)(F.ws + WS_W1) + (size_t)layer * 4096 * 1024; break;
        default: K = 4096; Ndst = 1024; Nsrc = 1024; W = a.mlp_w2 + (size_t)layer * 4096 * 1024; dst = (bf16*)(F.ws + WS_W2) + (size_t)layer * 1024 * 4096; break;
    }
    const int nblk = Ndst / 32, kb = item / nblk, nb = item % nblk, k0 = 64 * kb, n0 = 32 * nb;
    const int nd = n0 + (lane & 31); int sc = nd; float cs = 1.f;
    if (kind == 0) {
        if (even) {
            if (nd < EC_NQ) sc = nd;
            else if (nd < EC_FF) sc = nd + 8;
            else if (nd < EC_NG) sc = 1536 + (nd - EC_FF);
            else if (nd < EC_END) sc = nd;
            else sc = -1;
            if (nd < 512 || (nd >= EC_NQ && nd < EC_KC)) cs = C2_64;
        } else { if (nd < 1024) cs = C2_64; }
    } else if (kind == 2) cs = C2_128;
#pragma unroll 8
    for (int i = 0; i < 32; ++i) { const int kk = 2 * i + (lane >> 5); float v = 0.f;
        if (sc >= 0) { v = W[(size_t)(k0 + kk) * Nsrc + sc] * cs; if (gain) v *= gain[k0 + kk]; }
        scr[kk * 33 + (lane & 31)] = v; }
    LDS_WAIT(); asm volatile("" ::: "memory");
    const int c = lane & 7;
#pragma unroll
    for (int j = 0; j < 4; ++j) { const int n = (lane >> 3) + 8 * j; const LAS float* s = scr + (8 * c) * 33 + n;
        v4u o; o.x = pk2(s[0 * 33], s[1 * 33]); o.y = pk2(s[2 * 33], s[3 * 33]); o.z = pk2(s[4 * 33], s[5 * 33]); o.w = pk2(s[6 * 33], s[7 * 33]);
        *(GAS v4u*)(dst + (size_t)(n0 + n) * K + k0 + 8 * c) = o; }
    LDS_WAIT(); asm volatile("" ::: "memory");
}
__device__ __forceinline__ void p0_prologue(const Frame& F, const Args& A) {
    LAS float* scr = (LAS float*)(F.lds + RING_OFF + F.wave * 16384);
    const int gw = F.vcu * NWAVES + F.wave, NGW = F.G * NWAVES;
    constexpr int I0 = 16 * 96, I1 = 16 * 32, I2 = 16 * 16, I3 = 16 * 32, I4 = 8 * 32, I5 = 16 * 128, I6 = 64 * 32, IL = I0 + I1 + I2 + I3 + I4 + I5 + I6;
    for (int it = gw; it < DEPTH_ * IL; it += NGW) {
        const int layer = it / IL; int r = it % IL; int kind = 0;
        if (r >= I0) { r -= I0; kind = 1; if (r >= I1) { r -= I1; kind = 2; if (r >= I2) { r -= I2; kind = 3; if (r >= I3) { r -= I3; kind = 4; if (r >= I4) { r -= I4; kind = 5; if (r >= I5) { r -= I5; kind = 6; } } } } } }
        p0_weight_item(F, A, layer, kind, r, scr);
    }
    for (int m = gw; m < MM_; m += NGW) {
        const GAS f32x4* xr = (const GAS f32x4*)(A.mem + (size_t)m * D_) + F.lane; const GAS f32x4* gr = (const GAS f32x4*)A.mem_norm_g + F.lane;
        f32x4 v[4]; float s = 0.f;
#pragma unroll
        for (int j = 0; j < 4; ++j) { v[j] = xr[64 * j]; s += (v[j].x * v[j].x + v[j].y * v[j].y) + (v[j].z * v[j].z + v[j].w * v[j].w); }
        const float r = 1.0f / sqrtf(wave_sum(s) * (1.f / D_) + EPS_);
        GAS unsigned long long* o8 = (GAS unsigned long long*)((bf16*)(F.ws + WS_MEMN) + (size_t)m * D_) + F.lane;
#pragma unroll
        for (int j = 0; j < 4; ++j) { const f32x4 g = gr[64 * j]; o8[64 * j] = (unsigned long long)pk2(v[j].x * r * g.x, v[j].y * r * g.y) | ((unsigned long long)pk2(v[j].z * r * g.z, v[j].w * r * g.w) << 32); }
    }
    for (int m = gw; m < M_; m += NGW) {
        const GAS f32x4* xr = (const GAS f32x4*)(A.x + (size_t)m * D_) + F.lane; GAS f32x4* xo = (GAS f32x4*)(A.out + (size_t)m * D_) + F.lane;
        f32x4 v[4]; float s = 0.f;
#pragma unroll
        for (int j = 0; j < 4; ++j) { v[j] = xr[64 * j]; xo[64 * j] = v[j]; s += (v[j].x * v[j].x + v[j].y * v[j].y) + (v[j].z * v[j].z + v[j].w * v[j].w); }
        s = wave_sum(s);
        GAS unsigned long long* o8 = (GAS unsigned long long*)((bf16*)(F.ws + WS_XB) + (size_t)m * D_) + F.lane;
#pragma unroll
        for (int j = 0; j < 4; ++j) o8[64 * j] = (unsigned long long)pk2(v[j].x, v[j].y) | ((unsigned long long)pk2(v[j].z, v[j].w) << 32);
        if (F.lane < 16) ((GAS float*)(F.ws + WS_SS))[(size_t)m * 16 + F.lane] = (F.lane == 0) ? s : 0.f;
    }
}
__device__ __forceinline__ void final_norm(const Frame& F, const Args& A) {
    const int gw = F.vcu * NWAVES + F.wave, NGW = F.G * NWAVES;
    for (int m = gw; m < M_; m += NGW) {
        GAS f32x4* xr = (GAS f32x4*)(A.out + (size_t)m * D_) + F.lane; const GAS f32x4* gr = (const GAS f32x4*)A.final_norm_g + F.lane;
        f32x4 v[4]; float s = 0.f;
#pragma unroll
        for (int j = 0; j < 4; ++j) { v[j] = xr[64 * j]; s += (v[j].x * v[j].x + v[j].y * v[j].y) + (v[j].z * v[j].z + v[j].w * v[j].w); }
        const float r = 1.0f / sqrtf(wave_sum(s) * (1.f / D_) + EPS_);
#pragma unroll
        for (int j = 0; j < 4; ++j) { const f32x4 g = gr[64 * j]; xr[64 * j] = (f32x4){v[j].x * r * g.x, v[j].y * r * g.y, v[j].z * r * g.z, v[j].w * r * g.w}; }
    }
}
constexpr float NEGBIG = -3.0e38f;
__device__ __forceinline__ void stage_kv64(LAS float* Ks, LAS float* Vs, const bf16* kbase, const bf16* vbase, int pitch, int tid) {
    const int key = tid >> 3, d0 = (tid & 7) * 8; float kf[8], vf[8];
    ld8(kbase + (size_t)key * pitch + d0, kf); ld8(vbase + (size_t)key * pitch + d0, vf);
#pragma unroll
    for (int i = 0; i < 8; ++i) { Ks[key * 64 + d0 + i] = kf[i]; Vs[key * 64 + d0 + i] = vf[i]; }
}
__device__ __forceinline__ float dot64(const float (&q)[64], const LAS float* k) {
    float a0 = 0.f, a1 = 0.f, a2 = 0.f, a3 = 0.f;
#pragma unroll
    for (int d = 0; d < 64; d += 4) { const f32x4 kv = *(const LAS f32x4*)(k + d); a0 += q[d] * kv[0]; a1 += q[d + 1] * kv[1]; a2 += q[d + 2] * kv[2]; a3 += q[d + 3] * kv[3]; }
    return (a0 + a1) + (a2 + a3);
}
__device__ __forceinline__ float dot64p(const unsigned (&qp)[32], const LAS float* k) {
    float a0 = 0.f, a1 = 0.f, a2 = 0.f, a3 = 0.f;
#pragma unroll
    for (int d = 0; d < 64; d += 4) { const f32x4 kv = *(const LAS f32x4*)(k + d); const unsigned w0 = qp[d >> 1], w1 = qp[(d >> 1) + 1];
        a0 += __uint_as_float(w0 << 16) * kv[0]; a1 += __uint_as_float(w0 & 0xffff0000u) * kv[1]; a2 += __uint_as_float(w1 << 16) * kv[2]; a3 += __uint_as_float(w1 & 0xffff0000u) * kv[3]; }
    return (a0 + a1) + (a2 + a3);
}
__device__ __forceinline__ void load_q64p(const bf16* p, unsigned (&qp)[32]) {
#pragma unroll
    for (int i = 0; i < 8; ++i) { const v4u w = *(const v4u*)(p + 8 * i); qp[4 * i] = w.x; qp[4 * i + 1] = w.y; qp[4 * i + 2] = w.z; qp[4 * i + 3] = w.w; }
}
__device__ __forceinline__ void osm4(float& m, float& l, float (&o)[64], const float (&x)[4], const bool (&ok)[4], const LAS float* v) {
    float mn = m;
#pragma unroll
    for (int i = 0; i < 4; ++i) mn = fmaxf(mn, ok[i] ? x[i] : NEGBIG);
    const float sc = exp2f(m - mn); float p[4];
#pragma unroll
    for (int i = 0; i < 4; ++i) p[i] = ok[i] ? exp2f(x[i] - mn) : 0.f;
    l = l * sc + ((p[0] + p[1]) + (p[2] + p[3])); m = mn;
#pragma unroll
    for (int d = 0; d < 64; d += 4) { const f32x4 v0 = *(const LAS f32x4*)(v + d), v1 = *(const LAS f32x4*)(v + 64 + d), v2 = *(const LAS f32x4*)(v + 128 + d), v3 = *(const LAS f32x4*)(v + 192 + d);
#pragma unroll
        for (int i = 0; i < 4; ++i) o[d + i] = o[d + i] * sc + (p[0] * v0[i] + p[1] * v1[i]) + (p[2] * v2[i] + p[3] * v3[i]); }
}
__device__ __forceinline__ void load_q64(const bf16* p, float (&q)[64]) {
#pragma unroll
    for (int i = 0; i < 8; ++i) { float t8[8]; ld8(p + 8 * i, t8);
#pragma unroll
        for (int j = 0; j < 8; ++j) q[8 * i + j] = t8[j]; }
}
__device__ __forceinline__ void store_o64(bf16* p, const float (&o)[64], float s) {
#pragma unroll
    for (int i = 0; i < 8; ++i) { v4u w; w.x = pk2(o[8 * i] * s, o[8 * i + 1] * s); w.y = pk2(o[8 * i + 2] * s, o[8 * i + 3] * s); w.z = pk2(o[8 * i + 4] * s, o[8 * i + 5] * s); w.w = pk2(o[8 * i + 6] * s, o[8 * i + 7] * s);
        *(v4u*)(p + 8 * i) = w; }
}

__device__ __forceinline__ void fox_naive_unit(unsigned char* ws, LAS unsigned char* lds, int u, int tid) {
    const int b = u >> 5, h = (u >> 2) & 7, qb = u & 3, t = qb * 512 + tid; const size_t row = (size_t)b * T_ + t;
    LAS float* Fs = (LAS float*)lds; LAS float* Ks = Fs + 2048; LAS float* Vs = Ks + 4096; LAS float* tot = Vs + 4096;
    const bf16* PROJ = (const bf16*)(ws + WS_PROJ); bf16* AO = (bf16*)(ws + WS_AO);
    const float* lf = (const float*)(ws + WS_LF) + (size_t)(b * 8 + h) * 2048;
    __syncthreads();
    { const f32x4 v = *(const f32x4*)(lf + 4 * tid); const float p0 = v[0], p1 = p0 + v[1], p2 = p1 + v[2], p3 = p2 + v[3];
      tot[tid] = p3; __syncthreads(); int cur = 0;
      for (int off = 1; off < 512; off <<= 1) { float x = tot[cur * 512 + tid]; if (tid >= off) x += tot[cur * 512 + tid - off]; tot[(cur ^ 1) * 512 + tid] = x; cur ^= 1; __syncthreads(); }
      const float ex = tot[cur * 512 + tid] - p3; Fs[4 * tid] = ex + p0; Fs[4 * tid + 1] = ex + p1; Fs[4 * tid + 2] = ex + p2; Fs[4 * tid + 3] = ex + p3; }
    __syncthreads();
    const float Ft = Fs[t];
    float q[64], o[64]; load_q64(PROJ + row * NPROJ + EC_FQ + h * 64, q);
#pragma unroll
    for (int d = 0; d < 64; ++d) o[d] = 0.f;
    float m = NEGBIG, l = 0.f; const int ntile = qb * 8 + 8;
    for (int kt = 0; kt < ntile; ++kt) {
        __syncthreads();
        stage_kv64(Ks, Vs, PROJ + ((size_t)b * T_ + kt * 64) * NPROJ + EC_FK + h * 64, PROJ + ((size_t)b * T_ + kt * 64) * NPROJ + EC_FV + h * 64, NPROJ, tid);
        __syncthreads();
        if (kt * 64 <= t) {
            for (int j0 = 0; j0 < 64; j0 += 4) { float x[4]; bool ok[4];
#pragma unroll
                for (int i = 0; i < 4; ++i) { const int s = kt * 64 + j0 + i; ok[i] = s <= t; x[i] = dot64(q, Ks + (j0 + i) * 64) + (Ft - Fs[s]); }
                osm4(m, l, o, x, ok, Vs + j0 * 64); }
        }
    }
    store_o64(AO + row * 1024 + h * 64, o, 1.0f / l);
}
__device__ __forceinline__ void sb_naive_unit(unsigned char* ws, LAS unsigned char* lds, int u, int tid) {
    const int b = u >> 6, h = (u >> 2) & 15, qb = u & 3, t = qb * 512 + tid; const size_t row = (size_t)b * T_ + t;
    LAS float* Ks = (LAS float*)lds; LAS float* Vs = Ks + 4096;
    const bf16* PROJ = (const bf16*)(ws + WS_PROJ); bf16* AO = (bf16*)(ws + WS_AO);
    float q[64], o[64]; load_q64(PROJ + row * NPROJ + OC_SQ + h * 64, q);
#pragma unroll
    for (int d = 0; d < 64; ++d) o[d] = 0.f;
    float acc = 0.f;
    for (int kt = qb * 8 + 7; kt >= 0; --kt) {
        __syncthreads();
        stage_kv64(Ks, Vs, PROJ + ((size_t)b * T_ + kt * 64) * NPROJ + OC_SK + h * 64, PROJ + ((size_t)b * T_ + kt * 64) * NPROJ + OC_SV + h * 64, NPROJ, tid);
        __syncthreads();
        if (kt * 64 < t) {
            for (int j0 = 60; j0 >= 0; j0 -= 4) { float a[4];
#pragma unroll
                for (int i = 3; i >= 0; --i) { const int s = kt * 64 + j0 + i; const bool ok = s < t; const float y = dot64(q, Ks + (j0 + i) * 64);
                    const float L = fmaxf(y, 0.f) + log2f(1.0f + exp2f(-fabsf(y)));
                    a[i] = ok ? exp2f(y - L + acc) : 0.f; acc -= ok ? L : 0.f; }
                const LAS float* v = Vs + j0 * 64;
#pragma unroll
                for (int d = 0; d < 64; d += 4) { const f32x4 v0 = *(const LAS f32x4*)(v + d), v1 = *(const LAS f32x4*)(v + 64 + d), v2 = *(const LAS f32x4*)(v + 128 + d), v3 = *(const LAS f32x4*)(v + 192 + d);
#pragma unroll
                    for (int i = 0; i < 4; ++i) o[d + i] += (a[0] * v0[i] + a[1] * v1[i]) + (a[2] * v2[i] + a[3] * v3[i]); }
            }
        }
        if (__syncthreads_and(acc < -200.f)) break;
    }
    store_o64(AO + row * 1024 + h * 64, o, 1.0f);
}
__device__ __forceinline__ void compress_naive_unit(const Args& a, unsigned char* ws, LAS unsigned char* lds, int u, int layer, int tid) {
    const int b = u >> 2, g = (u >> 1) & 1, kv = u & 1, e2 = layer >> 1, lane = tid & 63, wave = tid >> 6;
    const bf16* PROJ = (const bf16*)(ws + WS_PROJ) + (size_t)b * T_ * NPROJ + (kv ? EC_VC : EC_KC) + g * 64;
    const float* pe = (kv ? a.cmp_pe_v : a.cmp_pe_k) + (size_t)e2 * 2048; const float* w1 = (kv ? a.cmp_w1_v : a.cmp_w1_k) + (size_t)e2 * 131072; const float* w2 = (kv ? a.cmp_w2_v : a.cmp_w2_k) + (size_t)e2 * 4096;
    float* out = (float*)(ws + (kv ? WS_VC : WS_KC)) + (size_t)(b * 2 + g) * 127 * 64;
    LAS float* xs = (LAS float*)lds + wave * 2176;
    LAS float* hs = xs + 2048;
    __syncthreads();
    for (int c = wave; c < 127; c += 8) {
        for (int i = lane; i < 2048; i += 64) { const int l = i >> 6, d = i & 63; xs[i] = bf2f(PROJ[(size_t)(16 * c + l) * NPROJ + d]) + pe[i]; }
        LDS_WAIT(); asm volatile("" ::: "memory");
        float acc = 0.f;
        for (int i = 0; i < 2048; i += 4) { const f32x4 xv = *(const LAS f32x4*)(xs + i);
            acc += xv[0] * w1[(size_t)i * 64 + lane]; acc += xv[1] * w1[(size_t)(i + 1) * 64 + lane]; acc += xv[2] * w1[(size_t)(i + 2) * 64 + lane]; acc += xv[3] * w1[(size_t)(i + 3) * 64 + lane]; }
        const float hg = 0.5f * acc * (1.0f + tanhf(0.7978845608028654f * (acc + 0.044715f * acc * acc * acc)));
        hs[lane] = hg; LDS_WAIT(); asm volatile("" ::: "memory");
        float o = 0.f;
        for (int e = 0; e < 64; ++e) o += hs[e] * w2[e * 64 + lane];
        out[(size_t)c * 64 + lane] = o;
        LDS_WAIT(); asm volatile("" ::: "memory");
    }
}
__device__ __forceinline__ void nsa_naive_unit(const Args& a, unsigned char* ws, LAS unsigned char* lds, int u, int tid) {
    const int b = u >> 5, g = (u >> 4) & 1, tb = u & 15, tl = tid & 127, r = tid >> 7, t = tb * 128 + tl, h = g * 4 + r; const size_t row = (size_t)b * T_ + t;
    LAS float* Ks = (LAS float*)lds; LAS float* Vs = Ks + 4096; LAS float* biasd = Vs + 4096  ; LAS float* slab = biasd + 528  ; LAS unsigned* selm = (LAS unsigned*)(slab + 16384)  ;
    const bf16* PROJ = (const bf16*)(ws + WS_PROJ); bf16* AO = (bf16*)(ws + WS_AO);
    __syncthreads();
    for (int i = tid; i < 4 * 129; i += NTHR) { const int rr = i / 129, dd = i % 129; const int bk = dd < 128 ? (int)T5_BUCKET[dd] : 31; biasd[rr * 132 + dd] = a.rel_bias[bk * 8 + g * 4 + rr] * LOG2E; }
    unsigned q[32]; float o[64]; load_q64p(PROJ + row * NPROJ + EC_NQ + h * 64, q);
    float* OF = (float*)(ws + WS_XB) + row * 512 + h * 64;
    const float* gt = (const float*)(ws + WS_GT) + row * 24 + h * 3; const float g0 = gt[0], g1 = gt[1], g2 = gt[2];
    const LAS float* bd = biasd + r * 132;
    const int nvalid = t >= 31 ? ((t - 31) >> 4) + 1 : 0;
    const float* KC = (const float*)(ws + WS_KC) + (size_t)(b * 2 + g) * 127 * 64; const float* VC = (const float*)(ws + WS_VC) + (size_t)(b * 2 + g) * 127 * 64;
    float m = NEGBIG, l = 0.f;
#pragma unroll
    for (int d = 0; d < 64; ++d) o[d] = 0.f;
    for (int ct = 0; ct < 2; ++ct) {
        __syncthreads();
        { const int key = tid >> 3, d0 = (tid & 7) * 8, c = ct * 64 + key;
#pragma unroll
          for (int i = 0; i < 8; ++i) { Ks[key * 64 + d0 + i] = c < 127 ? KC[(size_t)c * 64 + d0 + i] : 0.f; Vs[key * 64 + d0 + i] = c < 127 ? VC[(size_t)c * 64 + d0 + i] : 0.f; } }
        __syncthreads();
        if (ct * 64 < nvalid) {
            for (int j0 = 0; j0 < 64; j0 += 4) { float x[4]; bool ok[4];
#pragma unroll
                for (int i = 0; i < 4; ++i) { const int c = ct * 64 + j0 + i; ok[i] = c < nvalid; const int dist = ok[i] ? t - (16 * c + 31) : 0; x[i] = dot64p(q, Ks + (j0 + i) * 64) + bd[dist < 128 ? dist : 128]; }
                osm4(m, l, o, x, ok, Vs + j0 * 64); }
        }
    }
    const float il = nvalid > 0 ? 1.0f / l : 0.f;
#pragma unroll
    for (int d = 0; d < 64; d += 4) *(f32x4*)(OF + d) = (f32x4){g0 * il * o[d], g0 * il * o[d + 1], g0 * il * o[d + 2], g0 * il * o[d + 3]};
    { float prev = 0.f;
      for (int ct = 0; ct < 2; ++ct) {
        __syncthreads();
        { const int key = tid >> 3, d0 = (tid & 7) * 8, c = ct * 64 + key;
#pragma unroll
          for (int i = 0; i < 8; ++i) Ks[key * 64 + d0 + i] = c < 127 ? KC[(size_t)c * 64 + d0 + i] : 0.f; }
        __syncthreads();
        for (int nn = 0; nn < 16; ++nn) { float p[4];
#pragma unroll
            for (int i = 0; i < 4; ++i) { const int c = ct * 64 + nn * 4 + i; const bool ok = c < nvalid; const int dist = ok ? t - (16 * c + 31) : 0;
                const float x = dot64p(q, Ks + (nn * 4 + i) * 64) + bd[dist < 128 ? dist : 128]; p[i] = ok ? exp2f(x - m) * il : 0.f; }
            slab[(r * 128 + tl) * 32 + ct * 16 + nn] = prev + ((p[0] + p[1]) + (p[2] + p[3])); prev = p[3]; }
      } }
    __syncthreads();
    const int cur = t >> 6;
    if (tid < 128) {
        float s[32];
#pragma unroll
        for (int n = 0; n < 32; ++n) { const float v = (slab[(0 * 128 + tl) * 32 + n] + slab[(1 * 128 + tl) * 32 + n]) + (slab[(2 * 128 + tl) * 32 + n] + slab[(3 * 128 + tl) * 32 + n]);
            s[n] = (n > cur) ? -1.0f : ((n == 0 || n == cur || n == cur - 1) ? 1.0e4f : v); }
        unsigned mask = 0u;
        for (int k = 0; k < 8; ++k) { float best = -3.0e38f; int bi = 0;
#pragma unroll
            for (int n = 0; n < 32; ++n) if (s[n] > best) { best = s[n]; bi = n; }
#pragma unroll
            for (int n = 0; n < 32; ++n) s[n] = (n == bi) ? -3.0e38f : s[n];
            mask |= 1u << bi; }
        selm[tl] = mask;
    }
    __syncthreads();
    const unsigned mask = selm[tl];
    m = NEGBIG; l = 0.f;
#pragma unroll
    for (int d = 0; d < 64; ++d) o[d] = 0.f;
    for (int n = 0; n < 2 * tb + 2; ++n) {
        __syncthreads();
        stage_kv64(Ks, Vs, PROJ + ((size_t)b * T_ + n * 64) * NPROJ + EC_KSL + g * 64, PROJ + ((size_t)b * T_ + n * 64) * NPROJ + EC_VSL + g * 64, NPROJ, tid);
        __syncthreads();
        if (((mask >> n) & 1u) && n <= cur) {
            for (int j0 = 0; j0 < 64; j0 += 4) { float x[4]; bool ok[4];
#pragma unroll
                for (int i = 0; i < 4; ++i) { const int s = n * 64 + j0 + i; ok[i] = s <= t; const int dist = ok[i] ? t - s : 0; x[i] = dot64p(q, Ks + (j0 + i) * 64) + bd[dist < 128 ? dist : 128]; }
                osm4(m, l, o, x, ok, Vs + j0 * 64); }
        }
    }
    { const float s1 = g1 / l;
#pragma unroll
      for (int d = 0; d < 64; d += 4) { f32x4 v = *(const f32x4*)(OF + d); v[0] += s1 * o[d]; v[1] += s1 * o[d + 1]; v[2] += s1 * o[d + 2]; v[3] += s1 * o[d + 3]; *(f32x4*)(OF + d) = v; } }
    m = NEGBIG; l = 0.f;
#pragma unroll
    for (int d = 0; d < 64; ++d) o[d] = 0.f;
    { const int lo = tb * 128 - 255, kt_lo = lo > 0 ? (lo >> 6) : 0, kt_hi = 2 * tb + 1;
      for (int kt = kt_lo; kt <= kt_hi; ++kt) {
        __syncthreads();
        stage_kv64(Ks, Vs, PROJ + ((size_t)b * T_ + kt * 64) * NPROJ + EC_KWN + g * 64, PROJ + ((size_t)b * T_ + kt * 64) * NPROJ + EC_VWN + g * 64, NPROJ, tid);
        __syncthreads();
        if (kt * 64 <= t && kt * 64 + 63 > t - 256) {
            for (int j0 = 0; j0 < 64; j0 += 4) { float x[4]; bool ok[4];
#pragma unroll
                for (int i = 0; i < 4; ++i) { const int s = kt * 64 + j0 + i; ok[i] = (s <= t) && (t - s < 256); const int dist = ok[i] ? t - s : 0; x[i] = dot64p(q, Ks + (j0 + i) * 64) + bd[dist < 128 ? dist : 128]; }
                osm4(m, l, o, x, ok, Vs + j0 * 64); }
        }
      } }
    { const float s2 = g2 / l;
#pragma unroll
      for (int d = 0; d < 64; d += 4) { const f32x4 v = *(const f32x4*)(OF + d); o[d] = v[0] + s2 * o[d]; o[d + 1] = v[1] + s2 * o[d + 1]; o[d + 2] = v[2] + s2 * o[d + 2]; o[d + 3] = v[3] + s2 * o[d + 3]; } }
    store_o64(AO + row * 1024 + 512 + h * 64, o, 1.0f);
}
__device__ __forceinline__ void xattn_naive_unit(unsigned char* ws, LAS unsigned char* lds, int u, int tid) {
    const int b = u >> 5, xh = (u >> 3) & 3, qb = u & 7, tl = tid >> 1, half = tid & 1, t = qb * 256 + tl; const size_t row = (size_t)b * T_ + t;
    LAS float* Ks = (LAS float*)lds; LAS float* Vs = Ks + 8192;
    const bf16* QX = (const bf16*)(ws + WS_QX); bf16* AOX = (bf16*)(ws + WS_AOX); const bf16* KV = (const bf16*)(ws + WS_MEMKV) + (size_t)b * MEMLEN_ * 1024;
    float q[64], o[64]; load_q64(QX + row * 512 + xh * 128 + half * 64, q);
#pragma unroll
    for (int d = 0; d < 64; ++d) o[d] = 0.f;
    float m = NEGBIG, l = 0.f;
    for (int kt = 0; kt < 4; ++kt) {
        __syncthreads();
        { const int key = tid >> 3, d0 = (tid & 7) * 16; float kf[8], vf[8];
#pragma unroll
          for (int hh = 0; hh < 2; ++hh) { ld8(KV + (size_t)(kt * 64 + key) * 1024 + xh * 128 + d0 + hh * 8, kf); ld8(KV + (size_t)(kt * 64 + key) * 1024 + 512 + xh * 128 + d0 + hh * 8, vf);
#pragma unroll
            for (int i = 0; i < 8; ++i) { Ks[key * 128 + d0 + hh * 8 + i] = kf[i]; Vs[key * 128 + d0 + hh * 8 + i] = vf[i]; } } }
        __syncthreads();
        for (int j0 = 0; j0 < 64; j0 += 4) { float x[4]; bool ok[4];
#pragma unroll
            for (int i = 0; i < 4; ++i) { float part = 0.f; const LAS float* k = Ks + (j0 + i) * 128 + half * 64;
#pragma unroll
                for (int d = 0; d < 64; d += 4) { const f32x4 kv = *(const LAS f32x4*)(k + d); part += (q[d] * kv[0] + q[d + 1] * kv[1]) + (q[d + 2] * kv[2] + q[d + 3] * kv[3]); }
                x[i] = part + __shfl_xor(part, 1); ok[i] = true; }
            float mn = m;
#pragma unroll
            for (int i = 0; i < 4; ++i) mn = fmaxf(mn, x[i]);
            const float sc = exp2f(m - mn); float p[4];
#pragma unroll
            for (int i = 0; i < 4; ++i) p[i] = exp2f(x[i] - mn);
            l = l * sc + ((p[0] + p[1]) + (p[2] + p[3])); m = mn;
            const LAS float* v = Vs + j0 * 128 + half * 64;
#pragma unroll
            for (int d = 0; d < 64; d += 4) { const f32x4 v0 = *(const LAS f32x4*)(v + d), v1 = *(const LAS f32x4*)(v + 128 + d), v2 = *(const LAS f32x4*)(v + 256 + d), v3 = *(const LAS f32x4*)(v + 384 + d);
#pragma unroll
                for (int i = 0; i < 4; ++i) o[d + i] = o[d + i] * sc + (p[0] * v0[i] + p[1] * v1[i]) + (p[2] * v2[i] + p[3] * v3[i]); }
        }
    }
    store_o64(AOX + row * 512 + xh * 128 + half * 64, o, 1.0f / l);
}
constexpr int NPHASE = 2 + 9 * DEPTH_;
__host__ __device__ inline bool phase_empty(int ph) { if (ph == 0 || ph == NPHASE - 1) return false; const int l = (ph - 1) / 9, j = (ph - 1) % 9; return (j == 2) && (l & 1); }

struct GemmJob { int type; pg8::Gemm g; int cshift; pg8::bf16_t* O; int ldc; const float* ss; };

__device__ __forceinline__ GemmJob make_job(unsigned char* ws, float* X, int l, int j, int jb) {
    bf16* const XB = (bf16*)(ws + WS_XB); float* const SS = (float*)(ws + WS_SS); const bool even = (l & 1) == 0;
    if (j == 0) return GemmJob{even ? 0 : 1, pg8::Gemm{XB, (const bf16*)(ws + WS_WIN) + (size_t)l * NPROJ * 1024, M_, NPROJ, 1024}, 0, (bf16*)(ws + WS_PROJ), NPROJ, SS};
    if (j == 3) return GemmJob{3, pg8::Gemm{(const bf16*)(ws + WS_AO), (const bf16*)(ws + WS_WOUT) + (size_t)l * 1024 * 1024, M_, 1024, 1024}, 0, nullptr, 0, nullptr};
    if (j == 4) { if (jb == 0) return GemmJob{1, pg8::Gemm{XB, (const bf16*)(ws + WS_WQ) + (size_t)l * 512 * 1024, M_, 512, 1024}, 0, (bf16*)(ws + WS_QX), 512, SS};
                  return GemmJob{1, pg8::Gemm{(const bf16*)(ws + WS_MEMN), (const bf16*)(ws + WS_WKV) + (size_t)l * 1024 * 1024, MM_, 1024, 1024}, 128, (bf16*)(ws + WS_MEMKV), 1024, nullptr}; }
    if (j == 6) return GemmJob{3, pg8::Gemm{(const bf16*)(ws + WS_AOX), (const bf16*)(ws + WS_WO) + (size_t)l * 1024 * 512, M_, 1024, 512}, 0, nullptr, 0, nullptr};
    if (j == 7) return GemmJob{2, pg8::Gemm{XB, (const bf16*)(ws + WS_W1) + (size_t)l * 4096 * 1024, M_, FF_, 1024}, 0, (bf16*)(ws + WS_H), FF_, SS};
    return GemmJob{3, pg8::Gemm{(const bf16*)(ws + WS_H), (const bf16*)(ws + WS_W2) + (size_t)l * 1024 * 4096, M_, 1024, FF_}, 0, nullptr, 0, nullptr};
}

#define HAS(k) (PT < 0 || PT == (k))
template <int PT> __global__ void __launch_bounds__(NTHR, 2) fwd_kernel(Args args) {
    extern __shared__ __attribute__((aligned(16))) unsigned char lds_raw[];
    LAS unsigned char* lds = (LAS unsigned char*)lds_raw;
    volatile LAS unsigned* MISC = (volatile LAS unsigned*)(lds + MISC_OFF);
    const int tid = threadIdx.x;
    Frame F; F.lds = lds; F.tid = tid; F.lane = tid & 63; F.wave = __builtin_amdgcn_readfirstlane(tid >> 6); F.G = gridDim.x;
    { const int bx = blockIdx.x; F.vcu = (F.G % 8 == 0) ? (bx % 8) * (F.G / 8) + bx / 8 : bx; }
    F.ws = args.ws;
    unsigned char* ws = args.ws; gu32* ctl = (gu32*)(ws + WS_CTL);
    for (int u = tid; u < (LDS_BYTES - LDSCTL_OFF) / 4; u += NTHR) ((LAS unsigned*)(lds + LDSCTL_OFF))[u] = 0u;
    __syncthreads();
    const int lo = args.ph_lo, hi = args.ph_hi;
    int nne = 0; for (int p = lo; p < hi; ++p) nne += phase_empty(p) ? 0 : 1;
    XcdBarrier bar; bar.bar = (unsigned*)(ctl + CW_BAR); bar.x = 0; bar.st = nullptr;
    if (nne > 1) bar = xcd_barrier_post((unsigned*)(ctl + CW_BAR), MISC + 8);
    bool ran = false;
    float* const X = args.out; bf16* const XB = (bf16*)(ws + WS_XB); float* const SS = (float*)(ws + WS_SS);
    for (int ph = lo; ph < hi; ++ph) {
        if (phase_empty(ph)) continue;
        if (ran) xcd_barrier(bar);
        ran = true;
        if (ph == 0) { if constexpr (HAS(0)) p0_prologue(F, args); continue; }
        if (ph == NPHASE - 1) { if constexpr (HAS(9)) final_norm(F, args); continue; }
        const int l = (ph - 1) / 9, j = (ph - 1) % 9; const bool even = (l & 1) == 0;
        const int njobs = (j == 0 || j == 3 || j == 6 || j == 7 || j == 8) ? 1 : (j == 4 ? 2 : 0);
        for (int jb = 0; jb < njobs; ++jb) {
            const GemmJob J = make_job(ws, args.out, l, j, jb);
            pg8::StaticOrder S; S.init(J.g.M, J.g.N, F.G, (int)((blockIdx.x + F.G - J.cshift) % F.G));
            float* const LF = (float*)(ws + WS_LF); float* const GT = (float*)(ws + WS_GT); const float* bfg = args.b_forget + (l >> 1) * 8;
            if (J.type == 0) { if constexpr (HAS(1)) { pg8::EpiBf<0, true> E{J.O, J.ldc, J.ss, LF, GT, bfg}; pg8::gemm_phase<pg8::EpiBf<0, true>, pg8::StaticOrder, true, true>(lds + RING_OFF, J.g, S, E); } }
            else if (J.type == 1) { if constexpr (HAS(2)) { pg8::EpiBf<0, false> E{J.O, J.ldc, J.ss, nullptr, nullptr, nullptr}; pg8::gemm_phase<pg8::EpiBf<0, false>, pg8::StaticOrder, true, true>(lds + RING_OFF, J.g, S, E); } }
            else if (J.type == 2) { if constexpr (HAS(3)) { pg8::EpiBf<1, false> E{J.O, J.ldc, J.ss, nullptr, nullptr, nullptr}; pg8::gemm_phase<pg8::EpiBf<1, false>, pg8::StaticOrder, true, true>(lds + RING_OFF, J.g, S, E); } }
            else { if constexpr (HAS(4)) { pg8::EpiResid E{X, XB, SS}; pg8::gemm_phase<pg8::EpiResid, pg8::StaticOrder, false, true>(lds + RING_OFF, J.g, S, E); } }
        }
        if (j == 1) {
            if (even) { if constexpr (HAS(5)) { for (int u = blockIdx.x; u < 256 + 32; u += F.G) { if (u < 256) fox_naive_unit(ws, lds, u, tid); else compress_naive_unit(args, ws, lds, u - 256, l, tid); } } }
            else { if constexpr (HAS(6)) { for (int u = blockIdx.x; u < 512; u += F.G) sb_naive_unit(ws, lds, u, tid); } }
        } else if (j == 2) { if constexpr (HAS(7)) { for (int u = blockIdx.x; u < 256; u += F.G) nsa_naive_unit(args, ws, lds, u, tid); } }
        else if (j == 5) { if constexpr (HAS(8)) { for (int u = blockIdx.x; u < 256; u += F.G) xattn_naive_unit(ws, lds, u, tid); } }
    }
}

#ifndef MK_SINGLE
#define MK_SINGLE 0
#endif
#if MK_SINGLE
constexpr int NKERN = 1;
static const void* kern_ptr(int) { return (const void*)fwd_kernel<-1>; }
#else
constexpr int NKERN = 10;
static const void* kern_ptr(int k) {
    switch (k) { case 0: return (const void*)fwd_kernel<0>; case 1: return (const void*)fwd_kernel<1>; case 2: return (const void*)fwd_kernel<2>; case 3: return (const void*)fwd_kernel<3>; case 4: return (const void*)fwd_kernel<4>;
                 case 5: return (const void*)fwd_kernel<5>; case 6: return (const void*)fwd_kernel<6>; case 7: return (const void*)fwd_kernel<7>; case 8: return (const void*)fwd_kernel<8>; default: return (const void*)fwd_kernel<9>; }
}
static int phase_kernel(int ph) {
    if (ph == 0) return 0; if (ph == NPHASE - 1) return 9;
    const int l = (ph - 1) / 9, j = (ph - 1) % 9; const bool even = (l & 1) == 0;
    switch (j) { case 0: return even ? 1 : 2; case 1: return even ? 5 : 6; case 2: return 7; case 3: return 4; case 4: return 2; case 5: return 8; case 6: return 4; case 7: return 3; default: return 4; }
}
#endif
extern "C" void kernel_launch(void* const* d_in, const int* in_sizes, int n_in, void* d_out, int out_size, void* d_ws, size_t ws_size, hipStream_t stream) {
    static int grid = 0;
    if (grid == 0) {
        if (n_in != 24 || in_sizes[0] != M_ * D_ || out_size != M_ * D_ || ws_size < WS_END) { fprintf(stderr, "kernel_launch: unexpected problem (n_in %d, ws %zu); nothing launched\n", n_in, ws_size); grid = -1; return; }
        int dev = 0, cus = 0;
        if (hipGetDevice(&dev) != hipSuccess || hipDeviceGetAttribute(&cus, hipDeviceAttributeMultiprocessorCount, dev) != hipSuccess) { grid = -1; return; }
        for (int k = 0; k < NKERN; ++k) if (hipFuncSetAttribute(kern_ptr(k), hipFuncAttributeMaxDynamicSharedMemorySize, LDS_BYTES) != hipSuccess) { fprintf(stderr, "kernel_launch: hipFuncSetAttribute failed\n"); grid = -1; return; }
        (void)hipGetLastError();
        grid = cus;
    }
    if (grid < 0) return;
    (void)hipMemsetAsync((char*)d_ws + WS_CTL, 0, CTL_ZERO_BYTES, stream);
    Args a{};
    const float** ap = (const float**)&a;
    for (int i = 0; i < 24; ++i) ap[i] = (const float*)d_in[i];
    a.out = (float*)d_out; a.ws = (unsigned char*)d_ws;
#if MK_SINGLE
    a.ph_lo = 0; a.ph_hi = NPHASE;
    hipLaunchKernelGGL(fwd_kernel<-1>, dim3(grid), dim3(NTHR), LDS_BYTES, stream, a);
#else
    for (int ph = 0; ph < NPHASE; ++ph) { if (phase_empty(ph)) continue; a.ph_lo = ph; a.ph_hi = ph + 1; void* kargs[] = {&a};
        (void)hipLaunchKernel(kern_ptr(phase_kernel(ph)), dim3(grid), dim3(NTHR), kargs, LDS_BYTES, stream); }
#endif
}
```

```cpp
#include <hip/hip_runtime.h>
#include <cstdio>
#include <cstdint>
#include <cmath>
#define MK_SINGLE 1
#ifndef MK_SINGLE
#define MK_SINGLE 0
#endif
#ifndef USE_MFMA_FOX
#define USE_MFMA_FOX 1
#endif
#ifndef USE_MFMA_SB
#define USE_MFMA_SB 1
#endif
#ifndef USE_MFMA_XA
#define USE_MFMA_XA 1
#endif
#ifndef USE_MFMA_NSA
#define USE_MFMA_NSA 1
#endif
#ifndef USE_MFMA_CMP
#define USE_MFMA_CMP 1
#endif
namespace pg8 {
#define PG8_LAS __attribute__((address_space(3)))
typedef unsigned short bf16_t;
typedef short bf16x8 __attribute__((ext_vector_type(8)));
typedef float f32x4 __attribute__((ext_vector_type(4)));
typedef unsigned u32x4 __attribute__((ext_vector_type(4)));
constexpr int BM = 256, BK = 64, HALF = 128, HTB = HALF * BK * 2  , STAGE_BYTES = 8 * HTB, NXCD = 8, WGM = 8;

__host__ __device__ __forceinline__ int lds_byte(int r, int c) { const int st = (r >> 4) * 2 + (c >> 5), rr = r & 15, cc = c & 31, ob = rr * 64 + cc * 2; return st * 1024 + (ob ^ (((ob >> 9) & 1) << 5)); }
__host__ __device__ __forceinline__ void stage_rc(int b, int& R, int& C) { const int st = b / 1024, sb = b % 1024, swz = sb ^ (((sb >> 9) & 1) << 5); R = (st >> 1) * 16 + swz / 64; C = (st & 1) * 32 + (swz % 64) / 2; }
__host__ __device__ __forceinline__ int perm32(int rho) { const int n = rho >> 4, i = rho & 15; return 8 * (i >> 2) + 4 * n + (i & 3); }

struct Unit { int pm, pn; };
struct Gemm { const bf16_t* A; const bf16_t* Bt; int M, N, K; };

struct StaticOrder {
    int nM, nN, nwg, G, c;
    __host__ __device__ void init(int M, int N, int G_, int c_) { nM = M / BM; nN = N / BM; nwg = nM * nN; G = G_; c = c_; }
    __host__ __device__ bool next(int i, Unit& u) const {
        const long L = (long)i * G + c; if (L >= nwg) return false;
        int wgid = (int)L; { const int q = nwg / NXCD, r = nwg % NXCD, xcd = wgid % NXCD, off = wgid / NXCD; wgid = (xcd < r ? xcd * (q + 1) : r * (q + 1) + (xcd - r) * q) + off; }
        const int nig = WGM * nN, gid = wgid / nig, fm = gid * WGM, gsz = (nM - fm) < WGM ? (nM - fm) : WGM;
        u.pm = fm + ((wgid % nig) % gsz); u.pn = (wgid % nig) / gsz; return true;
    }
    __device__ __forceinline__ void a_ready(const Unit&) const {}
    __device__ __forceinline__ void done(const Unit&) const {}
};
__device__ __forceinline__ unsigned cvt_pk_bf16(float lo, float hi) { unsigned r; asm volatile("v_cvt_pk_bf16_f32 %0, %1, %2" : "=v"(r) : "v"(lo), "v"(hi)); return r; }
typedef float f32x2 __attribute__((ext_vector_type(2)));
constexpr float RMS_EPS = 1e-6f, LOG2E_F = 1.4426950408889634f;
__device__ __forceinline__ void store16_wt(void* p, u32x4 v) { asm volatile("global_store_dwordx4 %0, %1, off sc1\n\ts_nop 1" :: "v"(p), "v"(v) : "memory"); }
typedef unsigned u32x2e __attribute__((ext_vector_type(2)));
__device__ __forceinline__ void store8_wt(void* p, u32x2e v) { asm volatile("global_store_dwordx2 %0, %1, off sc1\n\ts_nop 1" :: "v"(p), "v"(v) : "memory"); }
__device__ __forceinline__ float row_rs(const float* ss, int row) {
    const f32x4* p = (const f32x4*)(ss + (size_t)row * 16);
    const f32x4 a = p[0], b = p[1], c = p[2], d = p[3];
    const float s = ((a[0] + a[1]) + (a[2] + a[3])) + ((b[0] + b[1]) + (b[2] + b[3])) + ((c[0] + c[1]) + (c[2] + c[3])) + ((d[0] + d[1]) + (d[2] + d[3]));
    return __builtin_amdgcn_rsqf(s * (1.0f / 1024.0f) + RMS_EPS);
}
template <int ACT, bool SPECIAL> struct EpiBf {
    static constexpr bool PERM = true, AFTER_DRAIN = false, INIT_ACC = false;
    bf16_t* O; int ldc; const float* ss; float* LF; float* GT; const float* bforget;
    __device__ __forceinline__ void operator()(const f32x4 (&acc)[2][2][4][2], const Unit& u, int wr, int wc, int fr, int fq) const {
        const int row0 = u.pm * BM + wr * 64 + fr;
        if (SPECIAL && u.pn == 11) {
            if (wc != 0) return;
#pragma unroll
            for (int ai = 0; ai < 2; ++ai)
#pragma unroll
                for (int m = 0; m < 4; ++m) {
                    const int row = row0 + ai * HALF + m * 16; const float r = row_rs(ss, row);
                    const f32x4 v0 = acc[ai][0][m][0] * r, v1 = acc[ai][0][m][1] * r;
                    const float v[8] = {v0[0], v0[1], v0[2], v0[3], v1[0], v1[1], v1[2], v1[3]};
                    if (fq == 0) { const int b = row >> 11, t = row & 2047;
#pragma unroll
                        for (int j = 0; j < 8; ++j) { const float x2 = (v[j] + bforget[j]) * LOG2E_F;
                            LF[(size_t)(b * 8 + j) * 2048 + t] = fminf(x2, 0.f) - __builtin_amdgcn_logf(1.0f + __builtin_amdgcn_exp2f(-fabsf(x2))); }
                    } else {
#pragma unroll
                        for (int j = 0; j < 8; ++j) GT[(size_t)row * 24 + 8 * (fq - 1) + j] = __builtin_amdgcn_rcpf(1.0f + __builtin_amdgcn_exp2f(-v[j] * LOG2E_F));
                    }
                }
            return;
        }
        const int col0 = u.pn * BM + wc * 32 + 8 * fq;
#pragma unroll
        for (int ai = 0; ai < 2; ++ai)
#pragma unroll
            for (int m = 0; m < 4; ++m) { const int row = row0 + ai * HALF + m * 16; const float r = ss ? row_rs(ss, row) : 1.0f; bf16_t* rowp = O + (size_t)row * ldc + col0;
#pragma unroll
                for (int bj = 0; bj < 2; ++bj) { f32x4 v0 = acc[ai][bj][m][0] * r, v1 = acc[ai][bj][m][1] * r;
                    if (ACT == 1) {
#pragma unroll
                        for (int i = 0; i < 4; ++i) { const float a = fmaxf(v0[i], 0.f), b = fmaxf(v1[i], 0.f); v0[i] = a * a; v1[i] = b * b; } }
                    u32x4 w; w.x = cvt_pk_bf16(v0[0], v0[1]); w.y = cvt_pk_bf16(v0[2], v0[3]); w.z = cvt_pk_bf16(v1[0], v1[1]); w.w = cvt_pk_bf16(v1[2], v1[3]);
                    *(u32x4*)(rowp + bj * HALF) = w; } }
    }
};
struct EpiResid {
    static constexpr bool PERM = true, AFTER_DRAIN = false, INIT_ACC = true;
    const float* Xin; float* Xout; bf16_t* XB; float* SS;
    __device__ __forceinline__ void init(f32x4 (&acc)[2][2][4][2], const Unit& u, int wr, int wc, int fr, int fq) const {
        const int row0 = u.pm * BM + wr * 64 + fr, col0 = u.pn * BM + wc * 32 + 8 * fq;
        if (Xin) {
#pragma unroll
        for (int ai = 0; ai < 2; ++ai)
#pragma unroll
            for (int m = 0; m < 4; ++m) { const size_t off = (size_t)(row0 + ai * HALF + m * 16) * 1024 + col0;
#pragma unroll
                for (int bj = 0; bj < 2; ++bj)
#pragma unroll
                    for (int n = 0; n < 2; ++n) acc[ai][bj][m][n] = *(const f32x4*)(Xin + off + bj * HALF + n * 4); }
        } else {
        u32x4 w[2][2][4];
#pragma unroll
        for (int ai = 0; ai < 2; ++ai)
#pragma unroll
            for (int m = 0; m < 4; ++m) { const size_t off = (size_t)(row0 + ai * HALF + m * 16) * 1024 + col0;
#pragma unroll
                for (int bj = 0; bj < 2; ++bj) w[ai][bj][m] = *(const u32x4*)(XB + off + bj * HALF); }
#pragma unroll
        for (int ai = 0; ai < 2; ++ai)
#pragma unroll
            for (int m = 0; m < 4; ++m)
#pragma unroll
                for (int bj = 0; bj < 2; ++bj) { const u32x4 x = w[ai][bj][m];
                    acc[ai][bj][m][0] = (f32x4){__builtin_bit_cast(float, x.x << 16), __builtin_bit_cast(float, x.x & 0xffff0000u), __builtin_bit_cast(float, x.y << 16), __builtin_bit_cast(float, x.y & 0xffff0000u)};
                    acc[ai][bj][m][1] = (f32x4){__builtin_bit_cast(float, x.z << 16), __builtin_bit_cast(float, x.z & 0xffff0000u), __builtin_bit_cast(float, x.w << 16), __builtin_bit_cast(float, x.w & 0xffff0000u)}; }
        }
    }
    __device__ __forceinline__ void operator()(const f32x4 (&acc)[2][2][4][2], const Unit& u, int wr, int wc, int fr, int fq) const {
        const int row0 = u.pm * BM + wr * 64 + fr, col0 = u.pn * BM + wc * 32 + 8 * fq;
#pragma unroll
        for (int ai = 0; ai < 2; ++ai)
#pragma unroll
            for (int m = 0; m < 4; ++m) { const int row = row0 + ai * HALF + m * 16; const size_t off = (size_t)row * 1024 + col0; float sq = 0.f;
#pragma unroll
                for (int bj = 0; bj < 2; ++bj) { const f32x4 x0 = acc[ai][bj][m][0], x1 = acc[ai][bj][m][1];
                    if (Xout) { *(f32x4*)(Xout + off + bj * HALF) = x0; *(f32x4*)(Xout + off + bj * HALF + 4) = x1; }
                    sq += ((x0[0] * x0[0] + x0[1] * x0[1]) + (x0[2] * x0[2] + x0[3] * x0[3])) + ((x1[0] * x1[0] + x1[1] * x1[1]) + (x1[2] * x1[2] + x1[3] * x1[3]));
                    u32x4 w; w.x = cvt_pk_bf16(x0[0], x0[1]); w.y = cvt_pk_bf16(x0[2], x0[3]); w.z = cvt_pk_bf16(x1[0], x1[1]); w.w = cvt_pk_bf16(x1[2], x1[3]);
                    *(u32x4*)(XB + off + bj * HALF) = w; }
                sq += __shfl_xor(sq, 16); sq += __shfl_xor(sq, 32);
                if (fq == 0) SS[(size_t)row * 16 + u.pn * 4 + wc] = sq; }
    }
};


template <class Epi, class Sched, bool ALIGN_EPI = false, bool SP2 = false>
__device__ __forceinline__ void gemm_phase(PG8_LAS unsigned char* lds, const Gemm g, const Sched& S, const Epi& E) {
    int tid_ = threadIdx.x; asm volatile("" : "+v"(tid_));
    const int tid = tid_, wid = __builtin_amdgcn_readfirstlane(tid >> 6), lane = tid & 63, wr = wid >> 2, wc = wid & 3, fr = lane & 15, fq = lane >> 4;
    const int K = g.K, nt = K / BK;
    unsigned voffA[2], voffB[2];
#pragma unroll
    for (int i = 0; i < 2; ++i) { int R, C; stage_rc(tid * 16 + i * 8192, R, C); const int Rb = Epi::PERM ? ((R & ~31) + perm32(R & 31)) : R;
        voffA[i] = (unsigned)(R * K + C) * 2u; voffB[i] = (unsigned)(Rb * K + C) * 2u; }
    const size_t kstep = (size_t)(BK * 2);
    const size_t hstep = (size_t)HALF * K * 2;
    const size_t tstep = 2 * hstep;
    const unsigned ldsw = (unsigned)wid * 1024u;
    const int aoff = lds_byte(wr * 64 + fr, fq * 8), boff = lds_byte(wc * 32 + fr, fq * 8);
#define PG8_SA(b, h) (((b) * 2 + (h)) * HTB)
#define PG8_SB(b, h) ((4 + (b) * 2 + (h)) * HTB)
#define PG8_STAGE(bufoff, gbase, voff) do { _Pragma("unroll") for (int _i = 0; _i < 2; ++_i) \
        __builtin_amdgcn_global_load_lds((const unsigned*)((const char*)(gbase) + (voff)[_i]), (PG8_LAS unsigned*)(lds + (bufoff) + ldsw + _i * 8192), 16, 0, 0); } while (0)
#define PG8_LDA(dst, b, h) do { _Pragma("unroll") for (int m = 0; m < 4; ++m) _Pragma("unroll") for (int k = 0; k < 2; ++k) dst[m][k] = *(const PG8_LAS bf16x8*)(lds + PG8_SA(b, h) + aoff + m * 2048 + k * 1024); } while (0)
#define PG8_LDB(dst, b, h) do { _Pragma("unroll") for (int n = 0; n < 2; ++n) _Pragma("unroll") for (int k = 0; k < 2; ++k) dst[n][k] = *(const PG8_LAS bf16x8*)(lds + PG8_SB(b, h) + boff + n * 2048 + k * 1024); } while (0)
#define PG8_MMA(ai, bj, At, Bt) do { __builtin_amdgcn_s_setprio(1); _Pragma("unroll") for (int m = 0; m < 4; ++m) _Pragma("unroll") for (int n = 0; n < 2; ++n) _Pragma("unroll") for (int k = 0; k < 2; ++k) \
        acc[ai][bj][m][n] = __builtin_amdgcn_mfma_f32_16x16x32_bf16(Bt[n][k], At[m][k], acc[ai][bj][m][n], 0, 0, 0); __builtin_amdgcn_s_setprio(0); } while (0)
#define PG8_WAIT_V(n) asm volatile("s_waitcnt vmcnt(" #n ")" ::: "memory")
#define PG8_WAIT_L(n) asm volatile("s_waitcnt lgkmcnt(" #n ")" ::: "memory")
#define PG8_BAR __builtin_amdgcn_s_barrier()
#define PG8_SCHED __builtin_amdgcn_sched_barrier(0)
    Unit cur, nxt; int ui = 0;
    if (!S.next(0, cur)) return;
    f32x4 acc[2][2][4][2];
    if constexpr (Epi::INIT_ACC) E.init(acc, cur, wr, wc, fr, fq);
    else {
#pragma unroll
    for (int a = 0; a < 2; ++a)
#pragma unroll
        for (int b = 0; b < 2; ++b)
#pragma unroll
            for (int m = 0; m < 4; ++m)
#pragma unroll
                for (int n = 0; n < 2; ++n) acc[a][b][m][n] = (f32x4){0.f, 0.f, 0.f, 0.f};
    }
    bf16x8 At[4][2], B0[2][2], B1[2][2];
    const char* cA = (const char*)g.A + (size_t)cur.pm * tstep; const char* cB = (const char*)g.Bt + (size_t)cur.pn * tstep;
    S.a_ready(cur);
    if constexpr (SP2) {
        PG8_STAGE(PG8_SB(0, 0), cB, voffB); PG8_STAGE(PG8_SB(0, 1), cB + hstep, voffB); PG8_STAGE(PG8_SA(0, 0), cA, voffA); PG8_STAGE(PG8_SA(0, 1), cA + hstep, voffA);
        if (wr == 1) PG8_BAR;
        PG8_WAIT_V(2); PG8_BAR;
        PG8_STAGE(PG8_SB(1, 0), cB + kstep, voffB); PG8_STAGE(PG8_SA(1, 0), cA + kstep, voffA); PG8_STAGE(PG8_SB(1, 1), cB + hstep + kstep, voffB);
        PG8_WAIT_V(6); PG8_BAR;
    } else {
        PG8_STAGE(PG8_SB(0, 0), cB, voffB); PG8_STAGE(PG8_SA(0, 0), cA, voffA); PG8_STAGE(PG8_SB(0, 1), cB + hstep, voffB); PG8_STAGE(PG8_SA(0, 1), cA + hstep, voffA);
        if (wr == 1) PG8_BAR;
        PG8_WAIT_V(4); PG8_BAR;
        PG8_STAGE(PG8_SB(1, 0), cB + kstep, voffB); PG8_STAGE(PG8_SA(1, 0), cA + kstep, voffA); PG8_STAGE(PG8_SB(1, 1), cB + hstep + kstep, voffB);
        PG8_WAIT_V(6); PG8_BAR;
    }
    for (;;) {
        const bool has_next = S.next(ui + 1, nxt);
        const char* nA = has_next ? (const char*)g.A + (size_t)nxt.pm * tstep : cA; const char* nB = has_next ? (const char*)g.Bt + (size_t)nxt.pn * tstep : cB;
        for (int t = 0; t < nt; t += 2) {
            const bool last = (t == nt - 2);
            const char* a1 = cA + (size_t)(t + 1) * kstep;
            const char* a2 = last ? nA : cA + (size_t)(t + 2) * kstep; const char* b2 = last ? nB : cB + (size_t)(t + 2) * kstep;
            const char* a3 = a2 + kstep; const char* b3 = b2 + kstep;
            if (last && has_next) S.a_ready(nxt);
            if constexpr (SP2) {
            PG8_LDB(B0, 0, 0); PG8_LDB(B1, 0, 1); PG8_SCHED; PG8_LDA(At, 0, 0); PG8_STAGE(PG8_SA(1, 1), a1 + hstep, voffA);
            PG8_WAIT_V(8); PG8_WAIT_L(0); PG8_BAR; PG8_MMA(0, 0, At, B0); PG8_MMA(0, 1, At, B1); PG8_BAR; PG8_SCHED;
            PG8_LDA(At, 0, 1); PG8_STAGE(PG8_SB(0, 0), b2, voffB); PG8_STAGE(PG8_SB(0, 1), b2 + hstep, voffB); PG8_STAGE(PG8_SA(0, 0), a2, voffA);
            PG8_WAIT_V(8); PG8_WAIT_L(0); PG8_BAR; PG8_MMA(1, 0, At, B0); PG8_MMA(1, 1, At, B1); PG8_BAR; PG8_SCHED;
            PG8_LDB(B0, 1, 0); PG8_LDB(B1, 1, 1); PG8_SCHED; PG8_LDA(At, 1, 0); PG8_STAGE(PG8_SA(0, 1), a2 + hstep, voffA);
            PG8_WAIT_V(8); PG8_WAIT_L(0); PG8_BAR; PG8_MMA(0, 0, At, B0); PG8_MMA(0, 1, At, B1); PG8_BAR; PG8_SCHED;
            PG8_LDA(At, 1, 1); PG8_STAGE(PG8_SB(1, 0), b3, voffB); PG8_STAGE(PG8_SB(1, 1), b3 + hstep, voffB); PG8_STAGE(PG8_SA(1, 0), a3, voffA);
            PG8_WAIT_V(8); PG8_WAIT_L(0); PG8_BAR; PG8_MMA(1, 0, At, B0); PG8_MMA(1, 1, At, B1); PG8_BAR; PG8_SCHED;
            } else {
            PG8_LDB(B0, 0, 0); PG8_SCHED; PG8_LDA(At, 0, 0); PG8_STAGE(PG8_SA(1, 1), a1 + hstep, voffA);
            PG8_WAIT_L(8); PG8_BAR; PG8_WAIT_L(0); PG8_MMA(0, 0, At, B0); PG8_BAR; PG8_SCHED;
            PG8_LDB(B1, 0, 1); PG8_STAGE(PG8_SB(0, 0), b2, voffB);
            PG8_BAR; PG8_WAIT_L(0); PG8_MMA(0, 1, At, B1); PG8_BAR;
            PG8_LDA(At, 0, 1); PG8_STAGE(PG8_SA(0, 0), a2, voffA);
            PG8_BAR; PG8_WAIT_L(0); PG8_MMA(1, 0, At, B0); PG8_BAR; PG8_SCHED;
            PG8_STAGE(PG8_SB(0, 1), b2 + hstep, voffB);
            PG8_WAIT_V(6); PG8_BAR; PG8_MMA(1, 1, At, B1); PG8_BAR;
            PG8_LDB(B0, 1, 0); PG8_SCHED; PG8_LDA(At, 1, 0); PG8_STAGE(PG8_SA(0, 1), a2 + hstep, voffA);
            PG8_WAIT_L(8); PG8_BAR; PG8_WAIT_L(0); PG8_MMA(0, 0, At, B0); PG8_BAR; PG8_SCHED;
            PG8_LDB(B1, 1, 1); PG8_STAGE(PG8_SB(1, 0), b3, voffB);
            PG8_BAR; PG8_WAIT_L(0); PG8_MMA(0, 1, At, B1); PG8_BAR;
            PG8_LDA(At, 1, 1); PG8_STAGE(PG8_SA(1, 0), a3, voffA);
            PG8_BAR; PG8_WAIT_L(0); PG8_MMA(1, 0, At, B0); PG8_BAR; PG8_SCHED;
            PG8_STAGE(PG8_SB(1, 1), b3 + hstep, voffB);
            PG8_WAIT_V(6); PG8_BAR; PG8_MMA(1, 1, At, B1); PG8_BAR;
            }
        }
        if constexpr (ALIGN_EPI) { if (wr == 0) PG8_BAR; }
        if constexpr (!Epi::AFTER_DRAIN) { E(acc, cur, wr, wc, fr, fq); S.done(cur); }
        if (!has_next) break;
        if constexpr (Epi::INIT_ACC) E.init(acc, nxt, wr, wc, fr, fq);
        else {
#pragma unroll
        for (int a = 0; a < 2; ++a)
#pragma unroll
            for (int b = 0; b < 2; ++b)
#pragma unroll
                for (int m = 0; m < 4; ++m)
#pragma unroll
                    for (int n = 0; n < 2; ++n) acc[a][b][m][n] = (f32x4){0.f, 0.f, 0.f, 0.f};
        }
        cur = nxt; cA = nA; cB = nB; ++ui;
        if constexpr (ALIGN_EPI) { if (wr == 1) PG8_BAR; }
    }
    PG8_WAIT_V(0);
    if constexpr (!ALIGN_EPI) { if (wr == 0) PG8_BAR; }
    PG8_BAR;
    if constexpr (Epi::AFTER_DRAIN) { E.fused(acc, cur, wr, wc, fr, fq, lds, wid, lane); S.done(cur); }
#undef PG8_SA
#undef PG8_SB
#undef PG8_STAGE
#undef PG8_LDA
#undef PG8_LDB
#undef PG8_MMA
#undef PG8_WAIT_V
#undef PG8_WAIT_L
#undef PG8_BAR
#undef PG8_SCHED
}
}
#define GAS __attribute__((address_space(1)))
#define LAS __attribute__((address_space(3)))
typedef unsigned short bf16;
typedef unsigned v4u __attribute__((ext_vector_type(4)));
typedef float f32x4 __attribute__((ext_vector_type(4)));
typedef short bf16x8 __attribute__((ext_vector_type(8)));
typedef GAS unsigned gu32;
typedef GAS unsigned long long gu64;
#define RLX_AGENT __ATOMIC_RELAXED, __HIP_MEMORY_SCOPE_AGENT
#define LDS_WAIT() asm volatile("s_waitcnt lgkmcnt(0)" ::: "memory")
#define VM_WAIT() asm volatile("s_waitcnt vmcnt(0)" ::: "memory")
__device__ __forceinline__ unsigned long long rt() { return __builtin_amdgcn_s_memrealtime(); }
__device__ __forceinline__ unsigned pk2(float lo, float hi) { typedef float f2_ __attribute__((ext_vector_type(2))); typedef __bf16 b2_ __attribute__((ext_vector_type(2))); f2_ v = {lo, hi}; b2_ b = __builtin_convertvector(v, b2_); return __builtin_bit_cast(unsigned, b); }
__device__ __forceinline__ unsigned f2bf(float f) { return pk2(f, 0.f) & 0xffffu; }
template <int CTRL> __device__ __forceinline__ float lane_dpp(float v) { return __builtin_bit_cast(float, __builtin_amdgcn_update_dpp(0, __builtin_bit_cast(int, v), CTRL, 0xf, 0xf, true)); }
template <int CTRL> __device__ __forceinline__ int lane_dpp_i(int v) { return __builtin_amdgcn_update_dpp(0, v, CTRL, 0xf, 0xf, true); }
constexpr int DPP_XOR1 = 0xB1, DPP_XOR2 = 0x4E, DPP_HALF_MIRROR = 0x141, DPP_MIRROR = 0x140;
__device__ __forceinline__ float lane_sum16(float v) { auto rr = __builtin_amdgcn_permlane16_swap(__builtin_bit_cast(unsigned, v), __builtin_bit_cast(unsigned, v), false, false); return __builtin_bit_cast(float, rr[0]) + __builtin_bit_cast(float, rr[1]); }
__device__ __forceinline__ float lane_sum32(float v) { auto rr = __builtin_amdgcn_permlane32_swap(__builtin_bit_cast(unsigned, v), __builtin_bit_cast(unsigned, v), false, false); return __builtin_bit_cast(float, rr[0]) + __builtin_bit_cast(float, rr[1]); }
#define XB_TMO      128
#define XB_XCNT(j)  (256  + 64 * (j))
#define XB_XSUB(j)  (1280 + 64 * (j))
#define XB_XGEN(j)  (2304 + 64 * (j))
#define XB_TOP      3328
#define XB_TOPGEN   3392
#define XCD_BAR_WORDS 3456
#define XB_SPIN_CAP (1u << 18)

__device__ __forceinline__ unsigned xb_ld(unsigned* p)              { return __hip_atomic_load(p, __ATOMIC_RELAXED, __HIP_MEMORY_SCOPE_AGENT); }
__device__ __forceinline__ unsigned xb_add(unsigned* p, unsigned v) { return __hip_atomic_fetch_add(p, v, __ATOMIC_RELAXED, __HIP_MEMORY_SCOPE_AGENT); }
__device__ __forceinline__ unsigned xb_xcc_id() { return (unsigned)__builtin_amdgcn_s_getreg((3 << 11) | 20) & 0xFu; }
#define XB_SPIN(cond, bar) do { unsigned _sp = 0; while (cond) { __builtin_amdgcn_s_sleep(1); \
    if ((++_sp & 255u) == 0u) { if (xb_ld(&(bar)[XB_TMO])) break; if (_sp > XB_SPIN_CAP) { atomicAdd(&(bar)[XB_TMO], 1u); break; } } } } while (0)

struct XcdBarrier {
    unsigned* bar; unsigned x;
    volatile LAS unsigned* st;
};

__device__ __forceinline__ XcdBarrier xcd_barrier_post(unsigned* bar, volatile LAS unsigned* st) {
    XcdBarrier b; b.bar = bar; b.x = xb_xcc_id(); b.st = st;
    if (threadIdx.x == 0) (void)xb_add(&bar[XB_XCNT(b.x)], 1u);
    return b;
}
__device__ __forceinline__ void xcd_barrier_complete(unsigned* bar, unsigned x, unsigned& nloc, unsigned& nx) {
    const unsigned G = gridDim.x * gridDim.y * gridDim.z;
    unsigned sum, cnt, mine, sp = 0u;
    for (;;) {
        sum = 0u; cnt = 0u; mine = 0u;
#pragma unroll
        for (unsigned j = 0; j < 16; ++j) { const unsigned c = xb_ld(&bar[XB_XCNT(j)]); sum += c; cnt += (c > 0u) ? 1u : 0u; mine = (j == x) ? c : mine; }
        if (sum == G) break;
        __builtin_amdgcn_s_sleep(1);
        if ((++sp & 255u) == 0u) { if (xb_ld(&bar[XB_TMO])) break; if (sp > XB_SPIN_CAP) { atomicAdd(&bar[XB_TMO], 1u); break; } }
    }
    nloc = mine > 0u ? mine : 1u; nx = cnt > 0u ? cnt : 1u;
}

__device__ __forceinline__ void xcd_barrier(const XcdBarrier& b) {
    asm volatile("s_waitcnt vmcnt(0)" ::: "memory");
    __syncthreads();
    if (threadIdx.x == 0) {
        unsigned* bar = b.bar;
        __builtin_amdgcn_s_waitcnt(0);
        unsigned nloc = b.st[0], nx = b.st[1];
        if (nloc == 0u) { xcd_barrier_complete(bar, b.x, nloc, nx); b.st[0] = nloc; b.st[1] = nx; }
        const unsigned old = xb_add(&bar[XB_XSUB(b.x)], 1u);
        const unsigned gen = old / nloc;
        if (old + 1u == (gen + 1u) * nloc) {
            __builtin_amdgcn_fence(__ATOMIC_RELEASE, "agent");
            asm volatile("s_waitcnt vmcnt(0)" ::: "memory");
            const unsigned og = xb_add(&bar[XB_TOP], 1u);
            const unsigned tg = og / nx;
            if (og + 1u == (tg + 1u) * nx) xb_add(&bar[XB_TOPGEN], 1u);
            else XB_SPIN(xb_ld(&bar[XB_TOPGEN]) == tg, bar);
            __builtin_amdgcn_fence(__ATOMIC_ACQUIRE, "agent");
            xb_add(&bar[XB_XGEN(b.x)], 1u);
            asm volatile("s_waitcnt vmcnt(0)" ::: "memory");
        } else {
            XB_SPIN(xb_ld(&bar[XB_XGEN(b.x)]) == gen, bar);
            __builtin_amdgcn_fence(__ATOMIC_ACQUIRE, "agent");
            asm volatile("s_waitcnt vmcnt(0)" ::: "memory");
        }
    }
    __syncthreads();
}
constexpr int NB_ = 8, T_ = 2048, D_ = 1024, M_ = NB_ * T_, DEPTH_ = 4, MEMLEN_ = 256, MM_ = NB_ * MEMLEN_, FF_ = 4096;
constexpr int NPROJ = 3072;
constexpr float LOG2E = 1.4426950408889634f, EPS_ = 1e-6f;
constexpr float C2_64 = 0.125f * LOG2E;
constexpr float C2_128 = 0.08838834764831845f * LOG2E;
constexpr int EC_FQ = 0, EC_FK = 512, EC_FV = 1024, EC_NQ = 1536, EC_KC = 2048, EC_VC = 2176, EC_KSL = 2304, EC_VSL = 2432, EC_KWN = 2560, EC_VWN = 2688, EC_FF = 2816, EC_NG = 2824, EC_END = 2848;
constexpr int OC_SQ = 0, OC_SK = 1024, OC_SV = 2048;

constexpr size_t MiB = 1u << 20;
constexpr size_t WS_CTL = 0, CTL_ZERO_BYTES = 64 * 1024;
constexpr size_t WS_SS = 1 * MiB;
constexpr size_t WS_LF = 2 * MiB;
constexpr size_t WS_GT = 3 * MiB;
constexpr size_t WS_KCB = 2 * MiB + 512 * 1024, WS_VCB = 2 * MiB + 768 * 1024;
constexpr size_t WS_CW1 = 4 * MiB + 512 * 1024;
constexpr size_t WS_CW2 = 5 * MiB + 512 * 1024, WS_CB1 = WS_CW2 + 64 * 1024;
constexpr size_t WS_KC = 5 * MiB + 768 * 1024, WS_VC = 6 * MiB + 384 * 1024;
constexpr size_t WS_MEMN = 7 * MiB;
constexpr size_t WS_MEMKV = 11 * MiB;
constexpr size_t WS_WIN = 16 * MiB, WS_WOUT = 40 * MiB, WS_WQ = 48 * MiB, WS_WKV = 52 * MiB, WS_WO = 60 * MiB, WS_W1 = 64 * MiB, WS_W2 = 96 * MiB;
constexpr size_t WS_XB = 128 * MiB;
constexpr size_t WS_ARENA = 160 * MiB;
constexpr size_t WS_PROJ = WS_ARENA, WS_AO = WS_ARENA + 96 * MiB, WS_QX = WS_ARENA, WS_AOX = WS_ARENA + 16 * MiB, WS_H = WS_ARENA;
constexpr size_t WS_END = 288 * MiB;
constexpr int CW_BAR = 4096;
constexpr int CW_CONV = 8192;
static_assert((CW_BAR + XCD_BAR_WORDS) * 4 <= (int)CTL_ZERO_BYTES, "ctl");
static_assert(WS_KC + 16 * 127 * 64 * 4 <= WS_VC && WS_VC + 16 * 127 * 64 * 4 <= WS_MEMN && WS_CB1 + 1024 <= WS_KC && WS_CW1 + 4 * 64 * 2048 * 2 <= WS_CW2 && WS_GT + (size_t)16384 * 24 * 4 <= WS_CW1 && WS_VCB + 16 * 128 * 64 * 2 <= WS_GT, "small-buffer map");

constexpr int RING_OFF = 0, RING_BYTES = 131072;
constexpr int LDS_BYTES = 147456;
constexpr int LDSCTL_OFF = LDS_BYTES - 512, MISC_OFF = LDSCTL_OFF + 320;
constexpr int NWAVES = 8, NTHR = 512;

__device__ const unsigned char T5_BUCKET[128] = {0, 1, 2, 3, 4, 5, 6, 7, 8, 9, 10, 11, 12, 13, 14, 15, 16, 16, 16, 17, 17, 18, 18, 18, 19, 19, 19, 20, 20, 20, 20, 21, 21, 21, 21, 22, 22, 22, 22, 22, 23, 23, 23, 23, 23, 23, 24, 24, 24, 24, 24, 24, 25, 25, 25, 25, 25, 25, 25, 26, 26, 26, 26, 26, 26, 26, 26, 27, 27, 27, 27, 27, 27, 27, 27, 27, 27, 28, 28, 28, 28, 28, 28, 28, 28, 28, 28, 29, 29, 29, 29, 29, 29, 29, 29, 29, 29, 29, 29, 30, 30, 30, 30, 30, 30, 30, 30, 30, 30, 30, 30, 30, 30, 31, 31, 31, 31, 31, 31, 31, 31, 31, 31, 31, 31, 31, 31, 31};

struct Args {
    const float *x, *mem, *rel_bias, *mem_norm_g, *norm_mix_g, *norm_xattn_g, *norm_mlp_g, *final_norm_g, *w_in_even, *b_forget, *cmp_pe_k, *cmp_w1_k, *cmp_w2_k, *cmp_pe_v, *cmp_w1_v, *cmp_w2_v,
        *w_out_even, *w_in_odd, *w_out_odd, *xa_wq, *xa_wkv, *xa_wo, *mlp_w1, *mlp_w2;
    float* out; unsigned char* ws; int ph_lo, ph_hi;
};
struct Frame {
    LAS unsigned char* lds; int tid, lane, wave, G, vcu;
    unsigned char* ws;
};
__device__ __forceinline__ const float* karg(int i) {
    auto ks = (const float* const __attribute__((address_space(4)))*)__builtin_amdgcn_kernarg_segment_ptr();
    asm volatile("" : "+s"(ks));
    return ks[i];
}
__device__ __forceinline__ float bf2f(unsigned short v) { return __uint_as_float((unsigned)v << 16); }
__device__ __forceinline__ float wave_sum(float v) {
#pragma unroll
    for (int o = 1; o < 64; o <<= 1) v += __shfl_xor(v, o);
    return v;
}
__device__ __forceinline__ void ld8(const bf16* p, float* o) {
    const v4u w = *(const v4u*)p;
    o[0] = __uint_as_float(w.x << 16); o[1] = __uint_as_float(w.x & 0xffff0000u); o[2] = __uint_as_float(w.y << 16); o[3] = __uint_as_float(w.y & 0xffff0000u);
    o[4] = __uint_as_float(w.z << 16); o[5] = __uint_as_float(w.z & 0xffff0000u); o[6] = __uint_as_float(w.w << 16); o[7] = __uint_as_float(w.w & 0xffff0000u);
}

struct WMeta { const float* gain; float cs; bf16* dst; int K, k0, n0; };
__device__ __forceinline__ void witem_load(const Frame& F, int layer, int kind, int item, f32x4 (&v)[16], WMeta& wm) {
    const int lane = F.lane; const bool even = (layer & 1) == 0; const int e2 = layer >> 1;
    const float* W; const float* gain = nullptr; int K, Nsrc, Ndst; bf16* dst;
    switch (kind) {
        case 0: K = 1024; Ndst = NPROJ; gain = karg(4) + layer * 1024; dst = (bf16*)(F.ws + WS_WIN) + (size_t)layer * NPROJ * 1024;
                if (even) { W = karg(8) + (size_t)e2 * 1024 * 2848; Nsrc = 2848; } else { W = karg(17) + (size_t)e2 * 1024 * 3072; Nsrc = 3072; } break;
        case 1: K = 1024; Ndst = 1024; Nsrc = 1024; W = (even ? karg(16) : karg(18)) + (size_t)e2 * 1024 * 1024; dst = (bf16*)(F.ws + WS_WOUT) + (size_t)layer * 1024 * 1024; break;
        case 2: K = 1024; Ndst = 512; Nsrc = 512; W = karg(19) + (size_t)layer * 1024 * 512; gain = karg(5) + layer * 1024; dst = (bf16*)(F.ws + WS_WQ) + (size_t)layer * 512 * 1024; break;
        case 3: K = 1024; Ndst = 1024; Nsrc = 1024; W = karg(20) + (size_t)layer * 1024 * 1024; dst = (bf16*)(F.ws + WS_WKV) + (size_t)layer * 1024 * 1024; break;
        case 4: K = 512; Ndst = 1024; Nsrc = 1024; W = karg(21) + (size_t)layer * 512 * 1024; dst = (bf16*)(F.ws + WS_WO) + (size_t)layer * 1024 * 512; break;
        case 5: K = 1024; Ndst = 4096; Nsrc = 4096; W = karg(22) + (size_t)layer * 1024 * 4096; gain = karg(6) + layer * 1024; dst = (bf16*)(F.ws + WS_W1) + (size_t)layer * 4096 * 1024; break;
        case 6: K = 4096; Ndst = 1024; Nsrc = 1024; W = karg(23) + (size_t)layer * 4096 * 1024; dst = (bf16*)(F.ws + WS_W2) + (size_t)layer * 1024 * 4096; break;
        case 7: K = 2048; Ndst = 64; Nsrc = 64; W = ((layer & 1) ? karg(14) : karg(11)) + (size_t)(layer >> 1) * 131072; dst = (bf16*)(F.ws + WS_CW1) + (size_t)layer * 64 * 2048; break;
        default: K = 64; Ndst = 64; Nsrc = 64; W = ((layer & 1) ? karg(15) : karg(12)) + (size_t)(layer >> 1) * 4096; dst = (bf16*)(F.ws + WS_CW2) + (size_t)layer * 64 * 64; break;
    }
    const int nblk = Ndst / 64, kb = item / nblk, nb = item % nblk, k0 = 64 * kb, n0 = 64 * nb;
    const int nd = n0 + 4 * (lane & 15); int sc = nd; float cs = 1.f;
    if (kind == 0) {
        if (even) {
            if (nd < EC_NQ) sc = nd;
            else if (nd < EC_FF) sc = nd + 8;
            else if (nd < EC_NG) sc = 1536 + (nd - EC_FF);
            else if (nd < EC_END) sc = nd;
            else sc = -1;
            if (nd < 512 || (nd >= EC_NQ && nd < EC_KC)) cs = C2_64;
        } else { if (nd < 1024) cs = C2_64; }
    } else if (kind == 2) cs = C2_128;
#pragma unroll
    for (int i = 0; i < 16; ++i) { const int kk = 4 * i + (lane >> 4); v[i] = (sc >= 0) ? __builtin_nontemporal_load((const f32x4*)(W + (size_t)(k0 + kk) * Nsrc + sc)) : (f32x4){0.f, 0.f, 0.f, 0.f}; }
    wm.gain = gain; wm.cs = cs; wm.dst = dst; wm.K = K; wm.k0 = k0; wm.n0 = n0;
}
__device__ __forceinline__ void witem_finish(const Frame& F, const f32x4 (&v)[16], const WMeta& wm, LAS float* scr) {
    const int lane = F.lane; const float* gain = wm.gain; const float cs = wm.cs; bf16* dst = wm.dst; const int K = wm.K, k0 = wm.k0, n0 = wm.n0;
#pragma unroll
    for (int i = 0; i < 16; ++i) { const int kk = 4 * i + (lane >> 4); const float sg = gain ? cs * gain[k0 + kk] : cs; *(LAS f32x4*)(scr + kk * 68 + ((4 * (lane & 15)) ^ (4 * ((kk >> 3) & 7)))) = v[i] * sg; }
    LDS_WAIT(); asm volatile("" ::: "memory");
    const int c = lane & 7;
#pragma unroll
    for (int i = 0; i < 8; ++i) { const int r = 8 * i + (lane >> 3); const LAS float* s = scr + (8 * c) * 68 + (r ^ (4 * c));
        v4u o; o.x = pk2(s[0 * 68], s[1 * 68]); o.y = pk2(s[2 * 68], s[3 * 68]); o.z = pk2(s[4 * 68], s[5 * 68]); o.w = pk2(s[6 * 68], s[7 * 68]);
        *(GAS v4u*)(dst + (size_t)(n0 + r) * K + k0 + 8 * c) = o; }
    LDS_WAIT(); asm volatile("" ::: "memory");
}
__device__ __forceinline__ void p0_weight_item(const Frame& F, const Args&, int layer, int kind, int item, LAS float* scr) { f32x4 v[16]; WMeta wm; witem_load(F, layer, kind, item, v, wm); witem_finish(F, v, wm, scr); }
__device__ __forceinline__ void convert_layer_weights(const Frame& F, const Args& A, int layer, int gw, int NGW) {
    LAS float* scr = (LAS float*)(F.lds + RING_OFF + F.wave * 17408);
    constexpr int I0 = 16 * 48, I1 = 16 * 16, I2 = 16 * 8, I3 = 16 * 16, I4 = 8 * 16, I5 = 16 * 64, I6 = 64 * 16, IL = I0 + I1 + I2 + I3 + I4 + I5 + I6;
    auto load = [&](int it, f32x4 (&v)[16], WMeta& wm) __attribute__((always_inline)) {
        int r = it; int kind = 0;
        if (r >= I0) { r -= I0; kind = 1; if (r >= I1) { r -= I1; kind = 2; if (r >= I2) { r -= I2; kind = 3; if (r >= I3) { r -= I3; kind = 4; if (r >= I4) { r -= I4; kind = 5; if (r >= I5) { r -= I5; kind = 6; } } } } } }
        witem_load(F, layer, kind, r, v, wm); };
    f32x4 va[16], vb[16]; WMeta ma, mb; int ita = gw;
    if (ita < IL) load(ita, va, ma);
    while (ita < IL) {
        const int itb = ita + NGW; if (itb < IL) load(itb, vb, mb);
        witem_finish(F, va, ma, scr);
        if (itb >= IL) break;
        ita = itb + NGW; if (ita < IL) load(ita, va, ma);
        witem_finish(F, vb, mb, scr);
    }
}
__device__ __forceinline__ void convert_layer_weights_queue(const Frame& F, const Args& A, int layer, gu32* ctr, LAS unsigned* lw) {
    LAS float* scr = (LAS float*)(F.lds + RING_OFF + F.wave * 17408);
    constexpr int I0 = 16 * 48, I1 = 16 * 16, I2 = 16 * 8, I3 = 16 * 16, I4 = 8 * 16, I5 = 16 * 64, I6 = 64 * 16, IL = I0 + I1 + I2 + I3 + I4 + I5 + I6;
    for (;;) {
        __syncthreads();
        if (F.tid == 0) *lw = __hip_atomic_fetch_add(ctr, 8u, __ATOMIC_RELAXED, __HIP_MEMORY_SCOPE_AGENT);
        __syncthreads();
        const int base = (int)*lw; if (base >= IL) break;
        const int it = base + F.wave;
        if (it < IL) { int r = it; int kind = 0;
            if (r >= I0) { r -= I0; kind = 1; if (r >= I1) { r -= I1; kind = 2; if (r >= I2) { r -= I2; kind = 3; if (r >= I3) { r -= I3; kind = 4; if (r >= I4) { r -= I4; kind = 5; if (r >= I5) { r -= I5; kind = 6; } } } } } }
            p0_weight_item(F, A, layer, kind, r, scr); }
    }
}
__device__ __forceinline__ void p0_prologue(const Frame& F, const Args& A) {
    LAS float* scr = (LAS float*)(F.lds + RING_OFF + F.wave * 17408);
    const int gw = F.vcu * NWAVES + F.wave, NGW = F.G * NWAVES;
    convert_layer_weights(F, A, 0, gw, NGW);
    for (int it = gw; it < 4 * 33; it += NGW) { const int mi = it / 33, r = it % 33; if (r < 32) p0_weight_item(F, A, mi, 7, r, scr); else p0_weight_item(F, A, mi, 8, 0, scr); }
    for (int it = gw; it < 256; it += NGW) { const int mi = it >> 6, e = it & 63; const float* pe = ((mi & 1) ? A.cmp_pe_v : A.cmp_pe_k) + (size_t)(mi >> 1) * 2048; const float* w1 = ((mi & 1) ? A.cmp_w1_v : A.cmp_w1_k) + (size_t)(mi >> 1) * 131072;
        float s = 0.f; for (int k = F.lane; k < 2048; k += 64) s += pe[k] * w1[(size_t)k * 64 + e];
        s = wave_sum(s); if (F.lane == 0) ((float*)(F.ws + WS_CB1))[it] = s; }
    for (int m = gw; m < MM_; m += NGW) {
        const GAS f32x4* xr = (const GAS f32x4*)(A.mem + (size_t)m * D_) + F.lane; const GAS f32x4* gr = (const GAS f32x4*)A.mem_norm_g + F.lane;
        f32x4 v[4]; float s = 0.f;
#pragma unroll
        for (int j = 0; j < 4; ++j) { v[j] = xr[64 * j]; s += (v[j].x * v[j].x + v[j].y * v[j].y) + (v[j].z * v[j].z + v[j].w * v[j].w); }
        const float r = 1.0f / sqrtf(wave_sum(s) * (1.f / D_) + EPS_);
        GAS unsigned long long* o8 = (GAS unsigned long long*)((bf16*)(F.ws + WS_MEMN) + (size_t)m * D_) + F.lane;
#pragma unroll
        for (int j = 0; j < 4; ++j) { const f32x4 g = gr[64 * j]; o8[64 * j] = (unsigned long long)pk2(v[j].x * r * g.x, v[j].y * r * g.y) | ((unsigned long long)pk2(v[j].z * r * g.z, v[j].w * r * g.w) << 32); }
    }
    for (int m0 = gw; m0 < M_; m0 += 4 * NGW) {
        f32x4 v[4][4];
#pragma unroll
        for (int q = 0; q < 4; ++q) { const int m = m0 + q * NGW; const GAS f32x4* xr = (const GAS f32x4*)(A.x + (size_t)(m < M_ ? m : M_ - 1) * D_) + F.lane;
#pragma unroll
            for (int j = 0; j < 4; ++j) v[q][j] = __builtin_nontemporal_load((const f32x4*)(xr + 64 * j)); }
#pragma unroll
        for (int q = 0; q < 4; ++q) { const int m = m0 + q * NGW; if (m >= M_) break; float s = 0.f;
#pragma unroll
            for (int j = 0; j < 4; ++j) s += (v[q][j].x * v[q][j].x + v[q][j].y * v[q][j].y) + (v[q][j].z * v[q][j].z + v[q][j].w * v[q][j].w);
            s = wave_sum(s);
            GAS unsigned long long* o8 = (GAS unsigned long long*)((bf16*)(F.ws + WS_XB) + (size_t)m * D_) + F.lane;
#pragma unroll
            for (int j = 0; j < 4; ++j) o8[64 * j] = (unsigned long long)pk2(v[q][j].x, v[q][j].y) | ((unsigned long long)pk2(v[q][j].z, v[q][j].w) << 32);
            if (F.lane < 16) ((GAS float*)(F.ws + WS_SS))[(size_t)m * 16 + F.lane] = (F.lane == 0) ? s : 0.f; }
    }
}
__device__ __forceinline__ void final_norm(const Frame& F, const Args& A) {
    const int gw = F.vcu * NWAVES + F.wave, NGW = F.G * NWAVES;
    for (int m = gw; m < M_; m += NGW) {
        GAS f32x4* xr = (GAS f32x4*)(A.out + (size_t)m * D_) + F.lane; const GAS f32x4* gr = (const GAS f32x4*)A.final_norm_g + F.lane;
        f32x4 v[4]; float s = 0.f;
#pragma unroll
        for (int j = 0; j < 4; ++j) { v[j] = xr[64 * j]; s += (v[j].x * v[j].x + v[j].y * v[j].y) + (v[j].z * v[j].z + v[j].w * v[j].w); }
        const float r = 1.0f / sqrtf(wave_sum(s) * (1.f / D_) + EPS_);
#pragma unroll
        for (int j = 0; j < 4; ++j) { const f32x4 g = gr[64 * j]; xr[64 * j] = (f32x4){v[j].x * r * g.x, v[j].y * r * g.y, v[j].z * r * g.z, v[j].w * r * g.w}; }
    }
}
constexpr float NEGBIG = -3.0e38f;
__device__ __forceinline__ void stage_kv64(LAS float* Ks, LAS float* Vs, const bf16* kbase, const bf16* vbase, int pitch, int tid) {
    const int key = tid >> 3, d0 = (tid & 7) * 8; float kf[8], vf[8];
    ld8(kbase + (size_t)key * pitch + d0, kf); ld8(vbase + (size_t)key * pitch + d0, vf);
#pragma unroll
    for (int i = 0; i < 8; ++i) { Ks[key * 64 + d0 + i] = kf[i]; Vs[key * 64 + d0 + i] = vf[i]; }
}
__device__ __forceinline__ float dot64(const float (&q)[64], const LAS float* k) {
    float a0 = 0.f, a1 = 0.f, a2 = 0.f, a3 = 0.f;
#pragma unroll
    for (int d = 0; d < 64; d += 4) { const f32x4 kv = *(const LAS f32x4*)(k + d); a0 += q[d] * kv[0]; a1 += q[d + 1] * kv[1]; a2 += q[d + 2] * kv[2]; a3 += q[d + 3] * kv[3]; }
    return (a0 + a1) + (a2 + a3);
}
__device__ __forceinline__ float dot64p(const unsigned (&qp)[32], const LAS float* k) {
    float a0 = 0.f, a1 = 0.f, a2 = 0.f, a3 = 0.f;
#pragma unroll
    for (int d = 0; d < 64; d += 4) { const f32x4 kv = *(const LAS f32x4*)(k + d); const unsigned w0 = qp[d >> 1], w1 = qp[(d >> 1) + 1];
        a0 += __uint_as_float(w0 << 16) * kv[0]; a1 += __uint_as_float(w0 & 0xffff0000u) * kv[1]; a2 += __uint_as_float(w1 << 16) * kv[2]; a3 += __uint_as_float(w1 & 0xffff0000u) * kv[3]; }
    return (a0 + a1) + (a2 + a3);
}
__device__ __forceinline__ void load_q64p(const bf16* p, unsigned (&qp)[32]) {
#pragma unroll
    for (int i = 0; i < 8; ++i) { const v4u w = *(const v4u*)(p + 8 * i); qp[4 * i] = w.x; qp[4 * i + 1] = w.y; qp[4 * i + 2] = w.z; qp[4 * i + 3] = w.w; }
}
__device__ __forceinline__ void osm4(float& m, float& l, float (&o)[64], const float (&x)[4], const bool (&ok)[4], const LAS float* v) {
    float mn = m;
#pragma unroll
    for (int i = 0; i < 4; ++i) mn = fmaxf(mn, ok[i] ? x[i] : NEGBIG);
    const float sc = exp2f(m - mn); float p[4];
#pragma unroll
    for (int i = 0; i < 4; ++i) p[i] = ok[i] ? exp2f(x[i] - mn) : 0.f;
    l = l * sc + ((p[0] + p[1]) + (p[2] + p[3])); m = mn;
#pragma unroll
    for (int d = 0; d < 64; d += 4) { const f32x4 v0 = *(const LAS f32x4*)(v + d), v1 = *(const LAS f32x4*)(v + 64 + d), v2 = *(const LAS f32x4*)(v + 128 + d), v3 = *(const LAS f32x4*)(v + 192 + d);
#pragma unroll
        for (int i = 0; i < 4; ++i) o[d + i] = o[d + i] * sc + (p[0] * v0[i] + p[1] * v1[i]) + (p[2] * v2[i] + p[3] * v3[i]); }
}
__device__ __forceinline__ void load_q64(const bf16* p, float (&q)[64]) {
#pragma unroll
    for (int i = 0; i < 8; ++i) { float t8[8]; ld8(p + 8 * i, t8);
#pragma unroll
        for (int j = 0; j < 8; ++j) q[8 * i + j] = t8[j]; }
}
__device__ __forceinline__ void store_o64(bf16* p, const float (&o)[64], float s) {
#pragma unroll
    for (int i = 0; i < 8; ++i) { v4u w; w.x = pk2(o[8 * i] * s, o[8 * i + 1] * s); w.y = pk2(o[8 * i + 2] * s, o[8 * i + 3] * s); w.z = pk2(o[8 * i + 4] * s, o[8 * i + 5] * s); w.w = pk2(o[8 * i + 6] * s, o[8 * i + 7] * s);
        *(v4u*)(p + 8 * i) = w; }
}

__device__ __forceinline__ void fox_naive_unit(unsigned char* ws, LAS unsigned char* lds, int u, int tid) {
    const int b = u >> 5, h = (u >> 2) & 7, qb = u & 3, t = qb * 512 + tid; const size_t row = (size_t)b * T_ + t;
    LAS float* Fs = (LAS float*)lds; LAS float* Ks = Fs + 2048; LAS float* Vs = Ks + 4096; LAS float* tot = Vs + 4096;
    const bf16* PROJ = (const bf16*)(ws + WS_PROJ); bf16* AO = (bf16*)(ws + WS_AO);
    const float* lf = (const float*)(ws + WS_LF) + (size_t)(b * 8 + h) * 2048;
    __syncthreads();
    { const f32x4 v = *(const f32x4*)(lf + 4 * tid); const float p0 = v[0], p1 = p0 + v[1], p2 = p1 + v[2], p3 = p2 + v[3];
      tot[tid] = p3; __syncthreads(); int cur = 0;
      for (int off = 1; off < 512; off <<= 1) { float x = tot[cur * 512 + tid]; if (tid >= off) x += tot[cur * 512 + tid - off]; tot[(cur ^ 1) * 512 + tid] = x; cur ^= 1; __syncthreads(); }
      const float ex = tot[cur * 512 + tid] - p3; Fs[4 * tid] = ex + p0; Fs[4 * tid + 1] = ex + p1; Fs[4 * tid + 2] = ex + p2; Fs[4 * tid + 3] = ex + p3; }
    __syncthreads();
    const float Ft = Fs[t];
    float q[64], o[64]; load_q64(PROJ + row * NPROJ + EC_FQ + h * 64, q);
#pragma unroll
    for (int d = 0; d < 64; ++d) o[d] = 0.f;
    float m = NEGBIG, l = 0.f; const int ntile = qb * 8 + 8;
    for (int kt = 0; kt < ntile; ++kt) {
        __syncthreads();
        stage_kv64(Ks, Vs, PROJ + ((size_t)b * T_ + kt * 64) * NPROJ + EC_FK + h * 64, PROJ + ((size_t)b * T_ + kt * 64) * NPROJ + EC_FV + h * 64, NPROJ, tid);
        __syncthreads();
        if (kt * 64 <= t) {
            for (int j0 = 0; j0 < 64; j0 += 4) { float x[4]; bool ok[4];
#pragma unroll
                for (int i = 0; i < 4; ++i) { const int s = kt * 64 + j0 + i; ok[i] = s <= t; x[i] = dot64(q, Ks + (j0 + i) * 64) + (Ft - Fs[s]); }
                osm4(m, l, o, x, ok, Vs + j0 * 64); }
        }
    }
    store_o64(AO + row * 1024 + h * 64, o, 1.0f / l);
}
__device__ __forceinline__ void sb_naive_unit(unsigned char* ws, LAS unsigned char* lds, int u, int tid) {
    const int b = u >> 6, h = (u >> 2) & 15, qb = u & 3, t = qb * 512 + tid; const size_t row = (size_t)b * T_ + t;
    LAS float* Ks = (LAS float*)lds; LAS float* Vs = Ks + 4096;
    const bf16* PROJ = (const bf16*)(ws + WS_PROJ); bf16* AO = (bf16*)(ws + WS_AO);
    float q[64], o[64]; load_q64(PROJ + row * NPROJ + OC_SQ + h * 64, q);
#pragma unroll
    for (int d = 0; d < 64; ++d) o[d] = 0.f;
    float acc = 0.f;
    for (int kt = qb * 8 + 7; kt >= 0; --kt) {
        __syncthreads();
        stage_kv64(Ks, Vs, PROJ + ((size_t)b * T_ + kt * 64) * NPROJ + OC_SK + h * 64, PROJ + ((size_t)b * T_ + kt * 64) * NPROJ + OC_SV + h * 64, NPROJ, tid);
        __syncthreads();
        if (kt * 64 < t) {
            for (int j0 = 60; j0 >= 0; j0 -= 4) { float a[4];
#pragma unroll
                for (int i = 3; i >= 0; --i) { const int s = kt * 64 + j0 + i; const bool ok = s < t; const float y = dot64(q, Ks + (j0 + i) * 64);
                    const float L = fmaxf(y, 0.f) + log2f(1.0f + exp2f(-fabsf(y)));
                    a[i] = ok ? exp2f(y - L + acc) : 0.f; acc -= ok ? L : 0.f; }
                const LAS float* v = Vs + j0 * 64;
#pragma unroll
                for (int d = 0; d < 64; d += 4) { const f32x4 v0 = *(const LAS f32x4*)(v + d), v1 = *(const LAS f32x4*)(v + 64 + d), v2 = *(const LAS f32x4*)(v + 128 + d), v3 = *(const LAS f32x4*)(v + 192 + d);
#pragma unroll
                    for (int i = 0; i < 4; ++i) o[d + i] += (a[0] * v0[i] + a[1] * v1[i]) + (a[2] * v2[i] + a[3] * v3[i]); }
            }
        }
        if (__syncthreads_and(acc < -200.f)) break;
    }
    store_o64(AO + row * 1024 + h * 64, o, 1.0f);
}
__device__ __forceinline__ void compress_naive_unit(const Args& a, unsigned char* ws, LAS unsigned char* lds, int u, int layer, int tid) {
    const int cch = u & 7; u >>= 3;
    const int b = u >> 2, g = (u >> 1) & 1, kv = u & 1, e2 = layer >> 1, lane = tid & 63, wave = tid >> 6;
    const bf16* PROJ = (const bf16*)(ws + WS_PROJ) + (size_t)b * T_ * NPROJ + (kv ? EC_VC : EC_KC) + g * 64;
    const float* pe = (kv ? a.cmp_pe_v : a.cmp_pe_k) + (size_t)e2 * 2048; const float* w1 = (kv ? a.cmp_w1_v : a.cmp_w1_k) + (size_t)e2 * 131072; const float* w2 = (kv ? a.cmp_w2_v : a.cmp_w2_k) + (size_t)e2 * 4096;
    float* out = (float*)(ws + (kv ? WS_VC : WS_KC)) + (size_t)(b * 2 + g) * 127 * 64;
    LAS float* xs = (LAS float*)lds + wave * 2176;
    LAS float* hs = xs + 2048;
    __syncthreads();
    for (int c = cch * 16 + wave; c < 127 && c < cch * 16 + 16; c += 8) {
        for (int i = lane; i < 2048; i += 64) { const int l = i >> 6, d = i & 63; xs[i] = bf2f(PROJ[(size_t)(16 * c + l) * NPROJ + d]) + pe[i]; }
        LDS_WAIT(); asm volatile("" ::: "memory");
        float acc = 0.f;
        for (int i = 0; i < 2048; i += 4) { const f32x4 xv = *(const LAS f32x4*)(xs + i);
            acc += xv[0] * w1[(size_t)i * 64 + lane]; acc += xv[1] * w1[(size_t)(i + 1) * 64 + lane]; acc += xv[2] * w1[(size_t)(i + 2) * 64 + lane]; acc += xv[3] * w1[(size_t)(i + 3) * 64 + lane]; }
        const float hg = 0.5f * acc * (1.0f + tanhf(0.7978845608028654f * (acc + 0.044715f * acc * acc * acc)));
        hs[lane] = hg; LDS_WAIT(); asm volatile("" ::: "memory");
        float o = 0.f;
        for (int e = 0; e < 64; ++e) o += hs[e] * w2[e * 64 + lane];
        out[(size_t)c * 64 + lane] = o;
        LDS_WAIT(); asm volatile("" ::: "memory");
    }
}
__device__ __forceinline__ void nsa_naive_unit(const Args& a, unsigned char* ws, LAS unsigned char* lds, int u, int tid) {
    const int b = u >> 5, g = (u >> 4) & 1, tb = u & 15, tl = tid & 127, r = tid >> 7, t = tb * 128 + tl, h = g * 4 + r; const size_t row = (size_t)b * T_ + t;
    LAS float* Ks = (LAS float*)lds; LAS float* Vs = Ks + 4096; LAS float* biasd = Vs + 4096  ; LAS float* slab = biasd + 528  ; LAS unsigned* selm = (LAS unsigned*)(slab + 16384)  ;
    const bf16* PROJ = (const bf16*)(ws + WS_PROJ); bf16* AO = (bf16*)(ws + WS_AO);
    __syncthreads();
    for (int i = tid; i < 4 * 129; i += NTHR) { const int rr = i / 129, dd = i % 129; const int bk = dd < 128 ? (int)T5_BUCKET[dd] : 31; biasd[rr * 132 + dd] = a.rel_bias[bk * 8 + g * 4 + rr] * LOG2E; }
    unsigned q[32]; float o[64]; load_q64p(PROJ + row * NPROJ + EC_NQ + h * 64, q);
    float* OF = (float*)(ws + WS_XB) + row * 512 + h * 64;
    const float* gt = (const float*)(ws + WS_GT) + row * 24 + h * 3; const float g0 = gt[0], g1 = gt[1], g2 = gt[2];
    const LAS float* bd = biasd + r * 132;
    const int nvalid = t >= 31 ? ((t - 31) >> 4) + 1 : 0;
    const float* KC = (const float*)(ws + WS_KC) + (size_t)(b * 2 + g) * 127 * 64; const float* VC = (const float*)(ws + WS_VC) + (size_t)(b * 2 + g) * 127 * 64;
    float m = NEGBIG, l = 0.f;
#pragma unroll
    for (int d = 0; d < 64; ++d) o[d] = 0.f;
    for (int ct = 0; ct < 2; ++ct) {
        __syncthreads();
        { const int key = tid >> 3, d0 = (tid & 7) * 8, c = ct * 64 + key;
#pragma unroll
          for (int i = 0; i < 8; ++i) { Ks[key * 64 + d0 + i] = c < 127 ? KC[(size_t)c * 64 + d0 + i] : 0.f; Vs[key * 64 + d0 + i] = c < 127 ? VC[(size_t)c * 64 + d0 + i] : 0.f; } }
        __syncthreads();
        if (ct * 64 < nvalid) {
            for (int j0 = 0; j0 < 64; j0 += 4) { float x[4]; bool ok[4];
#pragma unroll
                for (int i = 0; i < 4; ++i) { const int c = ct * 64 + j0 + i; ok[i] = c < nvalid; const int dist = ok[i] ? t - (16 * c + 31) : 0; x[i] = dot64p(q, Ks + (j0 + i) * 64) + bd[dist < 128 ? dist : 128]; }
                osm4(m, l, o, x, ok, Vs + j0 * 64); }
        }
    }
    const float il = nvalid > 0 ? 1.0f / l : 0.f;
#pragma unroll
    for (int d = 0; d < 64; d += 4) *(f32x4*)(OF + d) = (f32x4){g0 * il * o[d], g0 * il * o[d + 1], g0 * il * o[d + 2], g0 * il * o[d + 3]};
    { float prev = 0.f;
      for (int ct = 0; ct < 2; ++ct) {
        __syncthreads();
        { const int key = tid >> 3, d0 = (tid & 7) * 8, c = ct * 64 + key;
#pragma unroll
          for (int i = 0; i < 8; ++i) Ks[key * 64 + d0 + i] = c < 127 ? KC[(size_t)c * 64 + d0 + i] : 0.f; }
        __syncthreads();
        for (int nn = 0; nn < 16; ++nn) { float p[4];
#pragma unroll
            for (int i = 0; i < 4; ++i) { const int c = ct * 64 + nn * 4 + i; const bool ok = c < nvalid; const int dist = ok ? t - (16 * c + 31) : 0;
                const float x = dot64p(q, Ks + (nn * 4 + i) * 64) + bd[dist < 128 ? dist : 128]; p[i] = ok ? exp2f(x - m) * il : 0.f; }
            slab[(r * 128 + tl) * 32 + ct * 16 + nn] = prev + ((p[0] + p[1]) + (p[2] + p[3])); prev = p[3]; }
      } }
    __syncthreads();
    const int cur = t >> 6;
    if (tid < 128) {
        float s[32];
#pragma unroll
        for (int n = 0; n < 32; ++n) { const float v = (slab[(0 * 128 + tl) * 32 + n] + slab[(1 * 128 + tl) * 32 + n]) + (slab[(2 * 128 + tl) * 32 + n] + slab[(3 * 128 + tl) * 32 + n]);
            s[n] = (n > cur) ? -1.0f : ((n == 0 || n == cur || n == cur - 1) ? 1.0e4f : v); }
        unsigned mask = 0u;
        for (int k = 0; k < 8; ++k) { float best = -3.0e38f; int bi = 0;
#pragma unroll
            for (int n = 0; n < 32; ++n) if (s[n] > best) { best = s[n]; bi = n; }
#pragma unroll
            for (int n = 0; n < 32; ++n) s[n] = (n == bi) ? -3.0e38f : s[n];
            mask |= 1u << bi; }
        selm[tl] = mask;
    }
    __syncthreads();
    const unsigned mask = selm[tl];
    m = NEGBIG; l = 0.f;
#pragma unroll
    for (int d = 0; d < 64; ++d) o[d] = 0.f;
    for (int n = 0; n < 2 * tb + 2; ++n) {
        __syncthreads();
        stage_kv64(Ks, Vs, PROJ + ((size_t)b * T_ + n * 64) * NPROJ + EC_KSL + g * 64, PROJ + ((size_t)b * T_ + n * 64) * NPROJ + EC_VSL + g * 64, NPROJ, tid);
        __syncthreads();
        if (((mask >> n) & 1u) && n <= cur) {
            for (int j0 = 0; j0 < 64; j0 += 4) { float x[4]; bool ok[4];
#pragma unroll
                for (int i = 0; i < 4; ++i) { const int s = n * 64 + j0 + i; ok[i] = s <= t; const int dist = ok[i] ? t - s : 0; x[i] = dot64p(q, Ks + (j0 + i) * 64) + bd[dist < 128 ? dist : 128]; }
                osm4(m, l, o, x, ok, Vs + j0 * 64); }
        }
    }
    { const float s1 = g1 / l;
#pragma unroll
      for (int d = 0; d < 64; d += 4) { f32x4 v = *(const f32x4*)(OF + d); v[0] += s1 * o[d]; v[1] += s1 * o[d + 1]; v[2] += s1 * o[d + 2]; v[3] += s1 * o[d + 3]; *(f32x4*)(OF + d) = v; } }
    m = NEGBIG; l = 0.f;
#pragma unroll
    for (int d = 0; d < 64; ++d) o[d] = 0.f;
    { const int lo = tb * 128 - 255, kt_lo = lo > 0 ? (lo >> 6) : 0, kt_hi = 2 * tb + 1;
      for (int kt = kt_lo; kt <= kt_hi; ++kt) {
        __syncthreads();
        stage_kv64(Ks, Vs, PROJ + ((size_t)b * T_ + kt * 64) * NPROJ + EC_KWN + g * 64, PROJ + ((size_t)b * T_ + kt * 64) * NPROJ + EC_VWN + g * 64, NPROJ, tid);
        __syncthreads();
        if (kt * 64 <= t && kt * 64 + 63 > t - 256) {
            for (int j0 = 0; j0 < 64; j0 += 4) { float x[4]; bool ok[4];
#pragma unroll
                for (int i = 0; i < 4; ++i) { const int s = kt * 64 + j0 + i; ok[i] = (s <= t) && (t - s < 256); const int dist = ok[i] ? t - s : 0; x[i] = dot64p(q, Ks + (j0 + i) * 64) + bd[dist < 128 ? dist : 128]; }
                osm4(m, l, o, x, ok, Vs + j0 * 64); }
        }
      } }
    { const float s2 = g2 / l;
#pragma unroll
      for (int d = 0; d < 64; d += 4) { const f32x4 v = *(const f32x4*)(OF + d); o[d] = v[0] + s2 * o[d]; o[d + 1] = v[1] + s2 * o[d + 1]; o[d + 2] = v[2] + s2 * o[d + 2]; o[d + 3] = v[3] + s2 * o[d + 3]; } }
    store_o64(AO + row * 1024 + 512 + h * 64, o, 1.0f);
}
__device__ __forceinline__ void xattn_naive_unit(unsigned char* ws, LAS unsigned char* lds, int u, int tid) {
    const int b = u >> 5, xh = (u >> 3) & 3, qb = u & 7, tl = tid >> 1, half = tid & 1, t = qb * 256 + tl; const size_t row = (size_t)b * T_ + t;
    LAS float* Ks = (LAS float*)lds; LAS float* Vs = Ks + 8192;
    const bf16* QX = (const bf16*)(ws + WS_QX); bf16* AOX = (bf16*)(ws + WS_AOX); const bf16* KV = (const bf16*)(ws + WS_MEMKV) + (size_t)b * MEMLEN_ * 1024;
    float q[64], o[64]; load_q64(QX + row * 512 + xh * 128 + half * 64, q);
#pragma unroll
    for (int d = 0; d < 64; ++d) o[d] = 0.f;
    float m = NEGBIG, l = 0.f;
    for (int kt = 0; kt < 4; ++kt) {
        __syncthreads();
        { const int key = tid >> 3, d0 = (tid & 7) * 16; float kf[8], vf[8];
#pragma unroll
          for (int hh = 0; hh < 2; ++hh) { ld8(KV + (size_t)(kt * 64 + key) * 1024 + xh * 128 + d0 + hh * 8, kf); ld8(KV + (size_t)(kt * 64 + key) * 1024 + 512 + xh * 128 + d0 + hh * 8, vf);
#pragma unroll
            for (int i = 0; i < 8; ++i) { Ks[key * 128 + d0 + hh * 8 + i] = kf[i]; Vs[key * 128 + d0 + hh * 8 + i] = vf[i]; } } }
        __syncthreads();
        for (int j0 = 0; j0 < 64; j0 += 4) { float x[4]; bool ok[4];
#pragma unroll
            for (int i = 0; i < 4; ++i) { float part = 0.f; const LAS float* k = Ks + (j0 + i) * 128 + half * 64;
#pragma unroll
                for (int d = 0; d < 64; d += 4) { const f32x4 kv = *(const LAS f32x4*)(k + d); part += (q[d] * kv[0] + q[d + 1] * kv[1]) + (q[d + 2] * kv[2] + q[d + 3] * kv[3]); }
                x[i] = part + __shfl_xor(part, 1); ok[i] = true; }
            float mn = m;
#pragma unroll
            for (int i = 0; i < 4; ++i) mn = fmaxf(mn, x[i]);
            const float sc = exp2f(m - mn); float p[4];
#pragma unroll
            for (int i = 0; i < 4; ++i) p[i] = exp2f(x[i] - mn);
            l = l * sc + ((p[0] + p[1]) + (p[2] + p[3])); m = mn;
            const LAS float* v = Vs + j0 * 128 + half * 64;
#pragma unroll
            for (int d = 0; d < 64; d += 4) { const f32x4 v0 = *(const LAS f32x4*)(v + d), v1 = *(const LAS f32x4*)(v + 128 + d), v2 = *(const LAS f32x4*)(v + 256 + d), v3 = *(const LAS f32x4*)(v + 384 + d);
#pragma unroll
                for (int i = 0; i < 4; ++i) o[d + i] = o[d + i] * sc + (p[0] * v0[i] + p[1] * v1[i]) + (p[2] * v2[i] + p[3] * v3[i]); }
        }
    }
    store_o64(AOX + row * 512 + xh * 128 + half * 64, o, 1.0f / l);
}
namespace at {
typedef short bf16x8 __attribute__((ext_vector_type(8)));
typedef short s16x4 __attribute__((ext_vector_type(4)));
typedef short v4i16_t __attribute__((ext_vector_type(4)));
typedef float f32x16 __attribute__((ext_vector_type(16)));
typedef float f32x2_t __attribute__((ext_vector_type(2)));
typedef __bf16 bf16x2_t __attribute__((ext_vector_type(2)));
typedef LAS unsigned char* ldsp;
typedef const LAS unsigned char* cldsp;
constexpr float NINF = -INFINITY;
#if defined(SUBPROBE)
__device__ __forceinline__ void pr_mark(LAS unsigned char* lds, int i) { if (threadIdx.x == 0) { LAS unsigned long long* a = (LAS unsigned long long*)(lds + LDSCTL_OFF); const unsigned long long now = __builtin_amdgcn_s_memrealtime(); if (i >= 0) a[i] += now - a[4]; a[4] = now; } }
#define PR_MARK(i) at::pr_mark(lds, (i))
#else
#define PR_MARK(i) do {} while (0)
#endif
__device__ __forceinline__ unsigned cvtpk(float lo, float hi) { f32x2_t v = {lo, hi}; bf16x2_t b = __builtin_convertvector(v, bf16x2_t); return __builtin_bit_cast(unsigned, b); }
__device__ __forceinline__ s16x4 vtr(cldsp p) { return __builtin_bit_cast(s16x4, __builtin_amdgcn_ds_read_tr16_b64_v4i16((LAS v4i16_t*)p)); }
__device__ __forceinline__ float xhalf_max(float v) { auto rr = __builtin_amdgcn_permlane32_swap(__float_as_uint(v), __float_as_uint(v), false, false); return fmaxf(__uint_as_float(rr[0]), __uint_as_float(rr[1])); }
__device__ __forceinline__ float xhalf_sum(float v) { auto rr = __builtin_amdgcn_permlane32_swap(__float_as_uint(v), __float_as_uint(v), false, false); return __uint_as_float(rr[0]) + __uint_as_float(rr[1]); }
__device__ __forceinline__ bool wave_any(bool p) { return __builtin_amdgcn_ballot_w64(p) != 0ull; }
struct Stage { v4u k, v; };
__device__ __forceinline__ void ld_tile(Stage& s, const bf16* Kb, const bf16* Vb, int pitch, int wave, int lane) {
    const size_t off = (size_t)(8 * wave + (lane & 7)) * pitch + (lane >> 3) * 8;
    s.k = *(const v4u*)(Kb + off); s.v = *(const v4u*)(Vb + off);
}
__device__ __forceinline__ void st_tile(const Stage& s, ldsp Kslot, ldsp Vslot, int wave, int lane) {
    const int row = 8 * wave + (lane & 7), c = lane >> 3;
    *(LAS v4u*)(Kslot + c * 1024 + row * 16) = s.k; *(LAS v4u*)(Vslot + (c >> 2) * 4096 + row * 64 + (c & 3) * 16) = s.v;
}
__device__ __forceinline__ void qk64(f32x16& S0, f32x16& S1, cldsp Kslot, const bf16x8 (&qr)[4], int r32, int hi) {
    cldsp kb = Kslot + hi * 1024 + r32 * 16;
#pragma unroll
    for (int d0 = 0; d0 < 4; ++d0) { const bf16x8 b0 = *(const LAS bf16x8*)(kb + d0 * 2048), b1 = *(const LAS bf16x8*)(kb + d0 * 2048 + 512);
        S0 = __builtin_amdgcn_mfma_f32_32x32x16_bf16(b0, qr[d0], S0, 0, 0, 0); S1 = __builtin_amdgcn_mfma_f32_32x32x16_bf16(b1, qr[d0], S1, 0, 0, 0); }
}
__device__ __forceinline__ void qk64_c(f32x16& S0, f32x16& S1, cldsp Kslot, const bf16x8 (&qr)[4], const f32x16& C, int r32, int hi) {
    cldsp kb = Kslot + hi * 1024 + r32 * 16;
    { const bf16x8 b0 = *(const LAS bf16x8*)(kb), b1 = *(const LAS bf16x8*)(kb + 512);
      S0 = __builtin_amdgcn_mfma_f32_32x32x16_bf16(b0, qr[0], C, 0, 0, 0); S1 = __builtin_amdgcn_mfma_f32_32x32x16_bf16(b1, qr[0], C, 0, 0, 0); }
#pragma unroll
    for (int d0 = 1; d0 < 4; ++d0) { const bf16x8 b0 = *(const LAS bf16x8*)(kb + d0 * 2048), b1 = *(const LAS bf16x8*)(kb + d0 * 2048 + 512);
        S0 = __builtin_amdgcn_mfma_f32_32x32x16_bf16(b0, qr[d0], S0, 0, 0, 0); S1 = __builtin_amdgcn_mfma_f32_32x32x16_bf16(b1, qr[d0], S1, 0, 0, 0); }
}
__device__ __forceinline__ void pv64(f32x16 (&o)[2], cldsp vb, const v4u (&pa)[4]) {
#pragma unroll
    for (int db = 0; db < 2; ++db)
#pragma unroll
        for (int s = 0; s < 4; ++s) { const s16x4 lo = vtr(vb + db * 4096 + s * 1024), hi4 = vtr(vb + db * 4096 + s * 1024 + 512);
            const bf16x8 vf = {lo[0], lo[1], lo[2], lo[3], hi4[0], hi4[1], hi4[2], hi4[3]};
            o[db] = __builtin_amdgcn_mfma_f32_32x32x16_bf16(__builtin_bit_cast(bf16x8, pa[s]), vf, o[db], 0, 0, 0); }
}
struct Frags { bf16x8 kf[8]; s16x4 vlo[8], vhi[8]; };
__device__ __forceinline__ void load_frags(Frags& f, cldsp Kslot, cldsp vb, int r32, int hi) {
    cldsp kb = Kslot + hi * 1024 + r32 * 16;
#pragma unroll
    for (int d0 = 0; d0 < 4; ++d0) { f.kf[2 * d0] = *(const LAS bf16x8*)(kb + d0 * 2048); f.kf[2 * d0 + 1] = *(const LAS bf16x8*)(kb + d0 * 2048 + 512); }
#pragma unroll
    for (int i = 0; i < 8; ++i) { f.vlo[i] = vtr(vb + (i >> 2) * 4096 + (i & 3) * 1024); f.vhi[i] = vtr(vb + (i >> 2) * 4096 + (i & 3) * 1024 + 512); }
    __builtin_amdgcn_sched_barrier(0);
}
__device__ __forceinline__ void qk_mfma(f32x16& S0, f32x16& S1, const Frags& f, const bf16x8 (&qr)[4]) {
#pragma unroll
    for (int d0 = 0; d0 < 4; ++d0) { S0 = __builtin_amdgcn_mfma_f32_32x32x16_bf16(f.kf[2 * d0], qr[d0], S0, 0, 0, 0); S1 = __builtin_amdgcn_mfma_f32_32x32x16_bf16(f.kf[2 * d0 + 1], qr[d0], S1, 0, 0, 0); }
}
__device__ __forceinline__ void qk_mfma_c(f32x16& S0, f32x16& S1, const Frags& f, const bf16x8 (&qr)[4], const f32x16& C) {
    S0 = __builtin_amdgcn_mfma_f32_32x32x16_bf16(f.kf[0], qr[0], C, 0, 0, 0); S1 = __builtin_amdgcn_mfma_f32_32x32x16_bf16(f.kf[1], qr[0], C, 0, 0, 0);
#pragma unroll
    for (int d0 = 1; d0 < 4; ++d0) { S0 = __builtin_amdgcn_mfma_f32_32x32x16_bf16(f.kf[2 * d0], qr[d0], S0, 0, 0, 0); S1 = __builtin_amdgcn_mfma_f32_32x32x16_bf16(f.kf[2 * d0 + 1], qr[d0], S1, 0, 0, 0); }
}
__device__ __forceinline__ void pv_mfma(f32x16 (&o)[2], const Frags& f, const v4u (&pa)[4]) {
#pragma unroll
    for (int db = 0; db < 2; ++db)
#pragma unroll
        for (int sx = 0; sx < 4; ++sx) { const s16x4 lo = f.vlo[db * 4 + sx], hi4 = f.vhi[db * 4 + sx];
            const bf16x8 vf = {lo[0], lo[1], lo[2], lo[3], hi4[0], hi4[1], hi4[2], hi4[3]};
            o[db] = __builtin_amdgcn_mfma_f32_32x32x16_bf16(__builtin_bit_cast(bf16x8, pa[sx]), vf, o[db], 0, 0, 0); }
}
__device__ __forceinline__ int vbase(int lane) { return ((lane >> 4) & 1) * 32 + (lane & 3) * 8 + (4 * (lane >> 5) + ((lane & 15) >> 2)) * 64; }
template <int NDB> __device__ __forceinline__ void rows_scale(f32x16 (&o)[NDB], float v, LAS float* wsf, int r32, int hi) {
    if (hi == 0) wsf[r32] = v;
#pragma unroll
    for (int g = 0; g < 4; ++g) { const f32x4 a4 = *(const LAS f32x4*)(wsf + 8 * g + 4 * hi);
#pragma unroll
        for (int i = 0; i < 4; ++i) {
#pragma unroll
            for (int db = 0; db < NDB; ++db) o[db][4 * g + i] *= a4[i]; } }
}
template <bool FIRST> __device__ __forceinline__ void rows_fma(LAS float* ofl, const f32x16 (&o)[2], float v, LAS float* wsf, int r32, int hi, int lane) {
    if (hi == 0) wsf[r32] = v;
#pragma unroll
    for (int g = 0; g < 4; ++g) { const f32x4 a4 = *(const LAS f32x4*)(wsf + 8 * g + 4 * hi);
#pragma unroll
        for (int i = 0; i < 4; ++i) {
#pragma unroll
            for (int db = 0; db < 2; ++db) { LAS float* p = ofl + (db * 16 + 4 * g + i) * 64 + lane; const float x = o[db][4 * g + i] * a4[i]; *p = FIRST ? x : (*p + x); } } }
}
template <int NDB> __device__ __forceinline__ void osm64(f32x16& S0, f32x16& S1, float& m, float& l, f32x16 (&o)[NDB], LAS float* wsf, int r32, int hi, v4u (&pa)[4]) {
    float mt = fmaxf(S0[0], S1[0]);
#pragma unroll
    for (int r = 1; r < 16; ++r) mt = fmaxf(mt, fmaxf(S0[r], S1[r]));
    mt = xhalf_max(mt);
    const float mn = fmaxf(m, mt);
    if (wave_any(mn > m)) {
        const float msn = (mn == NINF) ? 0.f : mn;
        const float alpha = __builtin_amdgcn_exp2f(m - msn);
        l *= alpha; m = mn;
        rows_scale<NDB>(o, alpha, wsf, r32, hi);
    }
    const float ms = (m == NINF) ? 0.f : m;
    float ls = 0.f;
#pragma unroll
    for (int r = 0; r < 16; ++r) { S0[r] = __builtin_amdgcn_exp2f(S0[r] - ms); S1[r] = __builtin_amdgcn_exp2f(S1[r] - ms); ls += S0[r] + S1[r]; }
    l += ls;
    pa[0] = (v4u){cvtpk(S0[0], S0[1]), cvtpk(S0[2], S0[3]), cvtpk(S0[4], S0[5]), cvtpk(S0[6], S0[7])};
    pa[1] = (v4u){cvtpk(S0[8], S0[9]), cvtpk(S0[10], S0[11]), cvtpk(S0[12], S0[13]), cvtpk(S0[14], S0[15])};
    pa[2] = (v4u){cvtpk(S1[0], S1[1]), cvtpk(S1[2], S1[3]), cvtpk(S1[4], S1[5]), cvtpk(S1[6], S1[7])};
    pa[3] = (v4u){cvtpk(S1[8], S1[9]), cvtpk(S1[10], S1[11]), cvtpk(S1[12], S1[13]), cvtpk(S1[14], S1[15])};
}
constexpr float SM_THR = 8.0f;
struct SoftState { float nm, l; };
__device__ __forceinline__ void sm_init(SoftState& st, float base) { st.nm = base; st.l = 0.f; }
__device__ __forceinline__ f32x16 sm_tuple(const SoftState& st) { f32x16 c;
#pragma unroll
    for (int r = 0; r < 16; ++r) c[r] = st.nm;
    return c; }
#define MX3(a, b, c) __builtin_fmaxf(__builtin_fmaxf((a), (b)), (c))
template <int NDB> __device__ __forceinline__ void osm_lag(f32x16& S0, f32x16& S1, SoftState& st, bool first, f32x16 (&o)[NDB], LAS float* wsf, int r32, int hi, v4u (&pa)[4], bool live = true) {
    float a = MX3(S0[0], S0[1], S1[0]), b = MX3(S0[2], S0[3], S1[1]); a = MX3(a, S1[2], S1[3]);
#pragma unroll
    for (int r = 4; r < 16; r += 4) { a = MX3(a, S0[r], S0[r + 1]); b = MX3(b, S0[r + 2], S0[r + 3]); a = MX3(a, S1[r], S1[r + 1]); b = MX3(b, S1[r + 2], S1[r + 3]); }
    const float rm = live ? xhalf_max(__builtin_fmaxf(a, b)) : NINF;
    if (first || wave_any(rm > SM_THR)) {
        const float dl = first ? (rm > -1.0e30f ? rm : 0.f) : __builtin_fmaxf(rm, 0.f);
        st.nm -= dl;
#pragma unroll
        for (int r = 0; r < 16; ++r) { S0[r] -= dl; S1[r] -= dl; }
        const float f = __builtin_amdgcn_exp2f(-dl); st.l *= f;
        if (!first) rows_scale<NDB>(o, f, wsf, r32, hi);
    }
    float ls = 0.f;
#pragma unroll
    for (int r = 0; r < 16; ++r) { S0[r] = __builtin_amdgcn_exp2f(S0[r]); S1[r] = __builtin_amdgcn_exp2f(S1[r]); ls += S0[r] + S1[r]; }
    st.l += live ? ls : 0.f;
    const unsigned lm = live ? 0xffffffffu : 0u;
    pa[0] = (v4u){cvtpk(S0[0], S0[1]) & lm, cvtpk(S0[2], S0[3]) & lm, cvtpk(S0[4], S0[5]) & lm, cvtpk(S0[6], S0[7]) & lm};
    pa[1] = (v4u){cvtpk(S0[8], S0[9]) & lm, cvtpk(S0[10], S0[11]) & lm, cvtpk(S0[12], S0[13]) & lm, cvtpk(S0[14], S0[15]) & lm};
    pa[2] = (v4u){cvtpk(S1[0], S1[1]) & lm, cvtpk(S1[2], S1[3]) & lm, cvtpk(S1[4], S1[5]) & lm, cvtpk(S1[6], S1[7]) & lm};
    pa[3] = (v4u){cvtpk(S1[8], S1[9]) & lm, cvtpk(S1[10], S1[11]) & lm, cvtpk(S1[12], S1[13]) & lm, cvtpk(S1[14], S1[15]) & lm};
}
template <int NDB> __device__ __forceinline__ void osm_lag2(f32x16& S0, f32x16& S1, f32x16& S2, f32x16& S3, SoftState& st, bool first, f32x16 (&o)[NDB], LAS float* wsf, int r32, int hi, v4u (&pa)[8]) {
    float a = MX3(S0[0], S0[1], S1[0]), b = MX3(S0[2], S0[3], S1[1]), c = MX3(S2[0], S2[1], S3[0]), d = MX3(S2[2], S2[3], S3[1]); a = MX3(a, S1[2], S1[3]); c = MX3(c, S3[2], S3[3]);
#pragma unroll
    for (int r = 4; r < 16; r += 4) { a = MX3(a, S0[r], S0[r + 1]); b = MX3(b, S0[r + 2], S0[r + 3]); a = MX3(a, S1[r], S1[r + 1]); b = MX3(b, S1[r + 2], S1[r + 3]);
        c = MX3(c, S2[r], S2[r + 1]); d = MX3(d, S2[r + 2], S2[r + 3]); c = MX3(c, S3[r], S3[r + 1]); d = MX3(d, S3[r + 2], S3[r + 3]); }
    const float rm = xhalf_max(__builtin_fmaxf(__builtin_fmaxf(a, b), __builtin_fmaxf(c, d)));
    if (first || wave_any(rm > SM_THR)) {
        const float dl = first ? (rm > -1.0e30f ? rm : 0.f) : __builtin_fmaxf(rm, 0.f);
        st.nm -= dl;
#pragma unroll
        for (int r = 0; r < 16; ++r) { S0[r] -= dl; S1[r] -= dl; S2[r] -= dl; S3[r] -= dl; }
        const float f = __builtin_amdgcn_exp2f(-dl); st.l *= f;
        if (!first) rows_scale<NDB>(o, f, wsf, r32, hi);
    }
    float ls = 0.f, ls2 = 0.f;
#pragma unroll
    for (int r = 0; r < 16; ++r) { S0[r] = __builtin_amdgcn_exp2f(S0[r]); S1[r] = __builtin_amdgcn_exp2f(S1[r]); S2[r] = __builtin_amdgcn_exp2f(S2[r]); S3[r] = __builtin_amdgcn_exp2f(S3[r]); ls += S0[r] + S1[r]; ls2 += S2[r] + S3[r]; }
    st.l += ls + ls2;
    pa[0] = (v4u){cvtpk(S0[0], S0[1]), cvtpk(S0[2], S0[3]), cvtpk(S0[4], S0[5]), cvtpk(S0[6], S0[7])};
    pa[1] = (v4u){cvtpk(S0[8], S0[9]), cvtpk(S0[10], S0[11]), cvtpk(S0[12], S0[13]), cvtpk(S0[14], S0[15])};
    pa[2] = (v4u){cvtpk(S1[0], S1[1]), cvtpk(S1[2], S1[3]), cvtpk(S1[4], S1[5]), cvtpk(S1[6], S1[7])};
    pa[3] = (v4u){cvtpk(S1[8], S1[9]), cvtpk(S1[10], S1[11]), cvtpk(S1[12], S1[13]), cvtpk(S1[14], S1[15])};
    pa[4] = (v4u){cvtpk(S2[0], S2[1]), cvtpk(S2[2], S2[3]), cvtpk(S2[4], S2[5]), cvtpk(S2[6], S2[7])};
    pa[5] = (v4u){cvtpk(S2[8], S2[9]), cvtpk(S2[10], S2[11]), cvtpk(S2[12], S2[13]), cvtpk(S2[14], S2[15])};
    pa[6] = (v4u){cvtpk(S3[0], S3[1]), cvtpk(S3[2], S3[3]), cvtpk(S3[4], S3[5]), cvtpk(S3[6], S3[7])};
    pa[7] = (v4u){cvtpk(S3[8], S3[9]), cvtpk(S3[10], S3[11]), cvtpk(S3[12], S3[13]), cvtpk(S3[14], S3[15])};
}
template <int NDB> __device__ __forceinline__ void emit_o(const LAS float* stg, bf16* Ow, int pitch, int lane) {
#pragma unroll
    for (int i = 0; i < NDB * 2; ++i) { const int p = i * 64 + lane, c = p % (NDB * 4), q = p / (NDB * 4);
        const int db = c >> 2, col0 = (c & 3) * 8, r = (q & 3) + 4 * (q >> 3), hq = (q >> 2) & 1;
        const LAS float* src = stg + (db * 16 + r) * 64 + hq * 32 + col0; const f32x4 a = *(const LAS f32x4*)src, b = *(const LAS f32x4*)(src + 4);
        *(v4u*)(Ow + (size_t)q * pitch + c * 8) = (v4u){pk2(a[0], a[1]), pk2(a[2], a[3]), pk2(b[0], b[1]), pk2(b[2], b[3])}; }
}
template <int NDB> __device__ __forceinline__ void store_o(const f32x16 (&o)[NDB], LAS float* stg, bf16* Ow, int pitch, int lane) {
#pragma unroll
    for (int db = 0; db < NDB; ++db)
#pragma unroll
        for (int r = 0; r < 16; ++r) stg[(db * 16 + r) * 64 + lane] = o[db][r];
    asm volatile("s_waitcnt lgkmcnt(0)" ::: "memory");
    emit_o<NDB>(stg, Ow, pitch, lane);
}
__device__ __forceinline__ void load_q(bf16x8 (&qr)[4], const bf16* Qw, int pitch, int r32, int hi) {
#pragma unroll
    for (int d0 = 0; d0 < 4; ++d0) qr[d0] = *(const bf16x8*)(Qw + (size_t)r32 * pitch + d0 * 16 + hi * 8);
}
__device__ __forceinline__ void mask_causal(f32x16& S0, f32x16& S1, int tq, int hi) {
    asm volatile("" : "+v"(tq), "+v"(hi));
#pragma unroll
    for (int r = 0; r < 16; ++r) { const int k = (r & 3) + 8 * (r >> 2) + 4 * hi; if (k > tq) S0[r] = NINF; if (k + 32 > tq) S1[r] = NINF; }
}

constexpr int FX_FS = 0, FX_TOT = 8192, FX_K = 16384, FX_V = 49152, FX_WSF = 81920;
__device__ __forceinline__ void fox_unit(unsigned char* ws, ldsp lds, int b, int h, int qb, int tid) {
    const int lane = tid & 63, wave = __builtin_amdgcn_readfirstlane(tid >> 6), r32 = lane & 31, hi = lane >> 5;
    LAS float* Fs = (LAS float*)(lds + FX_FS); LAS float* tot = (LAS float*)(lds + FX_TOT); LAS float* wsf = (LAS float*)(lds + FX_WSF) + wave * 32;
    const bf16* PROJ = (const bf16*)(ws + WS_PROJ); bf16* AO = (bf16*)(ws + WS_AO);
    const float* lf = (const float*)(ws + WS_LF) + (size_t)(b * 8 + h) * 2048;
    const size_t row0 = (size_t)b * T_;
    const int q0 = qb * 256 + wave * 32;
    const f32x4 lfv = *(const f32x4*)(lf + 4 * tid);
    bf16x8 qr[4]; load_q(qr, PROJ + (row0 + q0) * NPROJ + EC_FQ + h * 64, NPROJ, r32, hi);
    const bf16* Kg = PROJ + row0 * NPROJ + EC_FK + h * 64; const bf16* Vg = PROJ + row0 * NPROJ + EC_FV + h * 64;
    const int ntile = 4 * qb + 4, my_last = 4 * qb + (wave >> 1), nstep = ntile / 2;
    struct Stage2 { Stage a, b; };
    Stage2 st; ld_tile(st.a, Kg + (size_t)(ntile - 1) * 64 * NPROJ, Vg + (size_t)(ntile - 1) * 64 * NPROJ, NPROJ, wave, lane); ld_tile(st.b, Kg + (size_t)(ntile - 2) * 64 * NPROJ, Vg + (size_t)(ntile - 2) * 64 * NPROJ, NPROJ, wave, lane);
    __syncthreads();
    {
      const float p0 = lfv[0], p1 = p0 + lfv[1], p2 = p1 + lfv[2], p3 = p2 + lfv[3];
      LAS float* wt = tot + wave * 128;
      wt[lane] = p3; int cur = 0; asm volatile("s_waitcnt lgkmcnt(0)" ::: "memory");
#pragma unroll
      for (int off = 1; off < 64; off <<= 1) { float x = wt[cur * 64 + lane]; if (lane >= off) x += wt[cur * 64 + lane - off]; wt[(cur ^ 1) * 64 + lane] = x; cur ^= 1; asm volatile("s_waitcnt lgkmcnt(0)" ::: "memory"); }
      const float incl = wt[cur * 64 + lane];
      if (lane == 63) tot[1024 + wave] = incl;
      __syncthreads();
      float base = 0.f;
#pragma unroll
      for (int w = 0; w < 8; ++w) base += (w < wave) ? tot[1024 + w] : 0.f;
      const float ex = base + incl - p3; *(LAS f32x4*)(Fs + 4 * tid) = (f32x4){-(ex + p0), -(ex + p1), -(ex + p2), -(ex + p3)}; }
    f32x16 o[2]; o[0] = (f32x16){0}; o[1] = (f32x16){0};
    SoftState sm; sm_init(sm, 0.f);
    const int vb = vbase(lane);
    auto ld2 = [&](Stage2& st, int T) __attribute__((always_inline)) { ld_tile(st.a, Kg + (size_t)(2 * T + 1) * 64 * NPROJ, Vg + (size_t)(2 * T + 1) * 64 * NPROJ, NPROJ, wave, lane); ld_tile(st.b, Kg + (size_t)(2 * T) * 64 * NPROJ, Vg + (size_t)(2 * T) * 64 * NPROJ, NPROJ, wave, lane); };
    auto fs_init = [&](f32x16& S0, f32x16& S1, int kt, float nm) __attribute__((always_inline)) {
#pragma unroll
        for (int g = 0; g < 4; ++g) { const f32x4 a = *(const LAS f32x4*)(Fs + kt * 64 + 8 * g + 4 * hi), c = *(const LAS f32x4*)(Fs + kt * 64 + 32 + 8 * g + 4 * hi);
#pragma unroll
            for (int i = 0; i < 4; ++i) { S0[4 * g + i] = a[i] + nm; S1[4 * g + i] = c[i] + nm; } } };
    for (int T = nstep - 1; T >= 0; --T) {
        const int slot = T & 1; ldsp KsA = lds + FX_K + slot * 16384, KsB = KsA + 8192, VsA = lds + FX_V + slot * 16384, VsB = VsA + 8192;
        st_tile(st.a, KsA, VsA, wave, lane); st_tile(st.b, KsB, VsB, wave, lane);
        __syncthreads();
        if (T >= 1) ld2(st, T - 1);
        if (2 * T <= my_last) {
            const bool hasA = 2 * T + 1 <= my_last; const float nm = sm.nm;
            f32x16 S0, S1, S2, S3;
            fs_init(S2, S3, 2 * T, nm); qk64(S2, S3, KsB, qr, r32, hi);
            if (hasA) { fs_init(S0, S1, 2 * T + 1, nm); qk64(S0, S1, KsA, qr, r32, hi); }
            else {
#pragma unroll
                for (int r = 0; r < 16; ++r) { S0[r] = NINF; S1[r] = NINF; } }
            if (2 * T + 1 == my_last) mask_causal(S0, S1, (wave & 1) * 32 + r32, hi);
            if (2 * T == my_last) mask_causal(S2, S3, (wave & 1) * 32 + r32, hi);
            v4u pa[8]; osm_lag2<2>(S0, S1, S2, S3, sm, (my_last >> 1) == T, o, wsf, r32, hi, pa);
            const v4u (&paA)[4] = *(const v4u (*)[4])&pa[0]; const v4u (&paB)[4] = *(const v4u (*)[4])&pa[4];
            if (hasA) pv64(o, VsA + vb, paA);
            pv64(o, VsB + vb, paB);
        }
    }
    { const float l = xhalf_sum(sm.l); rows_scale<2>(o, 1.0f / l, wsf, r32, hi); }
    __syncthreads();
    store_o<2>(o, (LAS float*)(lds + FX_K) + wave * 2048, AO + (row0 + q0) * 1024 + h * 64, 1024, lane);
}

constexpr int SB_K = 0, SB_V = 32768, SB_FLAG = 132096;
__device__ __forceinline__ void sb_unit(unsigned char* ws, ldsp lds, int b, int hp, int qb, int tid) {
    const int lane = tid & 63, wave = __builtin_amdgcn_readfirstlane(tid >> 6), r32 = lane & 31, hi = lane >> 5, hj = wave >> 2, sub = wave & 3, h = hp * 2 + hj;
    const bf16* PROJ = (const bf16*)(ws + WS_PROJ); bf16* AO = (bf16*)(ws + WS_AO);
    LAS unsigned* dflag = (LAS unsigned*)(lds + SB_FLAG);
    const size_t row0 = (size_t)b * T_; const int q0 = qb * 128 + sub * 32;
    __syncthreads();
    if (lane == 0) { dflag[wave] = 0u; dflag[8 + wave] = 0u; }
    bf16x8 qr[4]; load_q(qr, PROJ + (row0 + q0) * NPROJ + OC_SQ + h * 64, NPROJ, r32, hi);
    const bf16* Kg = PROJ + row0 * NPROJ + OC_SK + hp * 128; const bf16* Vg = PROJ + row0 * NPROJ + OC_SV + hp * 128;
    f32x16 o[2]; o[0] = (f32x16){0}; o[1] = (f32x16){0};
    float carry = 1.0f; bool done = false;
    const int vb = vbase(lane), tq = (sub & 1) * 32 + r32, kd = 2 * qb + (sub >> 1), ktop = 2 * qb + 1;
    auto step = [&](Stage (&st)[2], int kt, int buf) __attribute__((always_inline)) -> bool {
#pragma unroll
        for (int j = 0; j < 2; ++j) st_tile(st[j], lds + SB_K + buf * 16384 + j * 8192, lds + SB_V + buf * 16384 + j * 8192, wave, lane);
        __syncthreads();
        { LAS unsigned* fr = dflag + (buf ^ 1) * 8; const unsigned f0 = fr[0] & fr[1] & fr[2] & fr[3] & fr[4] & fr[5] & fr[6] & fr[7]; if (f0) return true; }
        if (kt >= 2) {
#pragma unroll
            for (int j = 0; j < 2; ++j) ld_tile(st[j], Kg + (size_t)(kt - 2) * 64 * NPROJ + j * 64, Vg + (size_t)(kt - 2) * 64 * NPROJ + j * 64, NPROJ, wave, lane);
        }
        if (!done && kt <= kd) {
            ldsp Ks = lds + SB_K + buf * 16384 + hj * 8192; ldsp Vs = lds + SB_V + buf * 16384 + hj * 8192;
            f32x16 Y0 = (f32x16){0}, Y1 = (f32x16){0};
            qk64(Y0, Y1, Ks, qr, r32, hi);
            f32x16 C0, C1;
#pragma unroll
            for (int r = 0; r < 16; ++r) { const float u0 = __builtin_amdgcn_exp2f(fminf(Y0[r], 80.f)), u1 = __builtin_amdgcn_exp2f(fminf(Y1[r], 80.f));
                C0[r] = __builtin_amdgcn_rcpf(1.0f + u0); C1[r] = __builtin_amdgcn_rcpf(1.0f + u1); Y0[r] = u0 * C0[r]; Y1[r] = u1 * C1[r]; }
            if (kt == kd) { int tq_ = tq, hi_ = hi; asm volatile("" : "+v"(tq_), "+v"(hi_));
#pragma unroll
                for (int r = 0; r < 16; ++r) { const int k = (r & 3) + 8 * (r >> 2) + 4 * hi_; if (k >= tq_) { C0[r] = 1.0f; Y0[r] = 0.f; } if (k + 32 >= tq_) { C1[r] = 1.0f; Y1[r] = 0.f; } }
            }
            float gp[16];
#pragma unroll
            for (int g = 0; g < 4; ++g) {
                const float p0 = (C0[4 * g] * C0[4 * g + 1]) * (C0[4 * g + 2] * C0[4 * g + 3]), p1 = (C1[4 * g] * C1[4 * g + 1]) * (C1[4 * g + 2] * C1[4 * g + 3]);
                auto r0 = __builtin_amdgcn_permlane32_swap(__float_as_uint(p0), __float_as_uint(p0), false, false); auto r1 = __builtin_amdgcn_permlane32_swap(__float_as_uint(p1), __float_as_uint(p1), false, false);
                gp[2 * g] = __uint_as_float(r0[0]); gp[2 * g + 1] = __uint_as_float(r0[1]); gp[8 + 2 * g] = __uint_as_float(r1[0]); gp[8 + 2 * g + 1] = __uint_as_float(r1[1]); }
            float suf[16]; suf[15] = carry;
#pragma unroll
            for (int G = 14; G >= 0; --G) suf[G] = suf[G + 1] * gp[G + 1];
            const float ncarry = suf[0] * gp[0];
#pragma unroll
            for (int g = 0; g < 4; ++g) {
                float la = hi ? suf[2 * g + 1] : suf[2 * g];
                { const float a3 = Y0[4 * g + 3] * la; la *= C0[4 * g + 3]; const float a2 = Y0[4 * g + 2] * la; la *= C0[4 * g + 2]; const float a1 = Y0[4 * g + 1] * la; la *= C0[4 * g + 1]; const float a0 = Y0[4 * g] * la;
                  Y0[4 * g] = a0; Y0[4 * g + 1] = a1; Y0[4 * g + 2] = a2; Y0[4 * g + 3] = a3; }
                float lb = hi ? suf[8 + 2 * g + 1] : suf[8 + 2 * g];
                { const float a3 = Y1[4 * g + 3] * lb; lb *= C1[4 * g + 3]; const float a2 = Y1[4 * g + 2] * lb; lb *= C1[4 * g + 2]; const float a1 = Y1[4 * g + 1] * lb; lb *= C1[4 * g + 1]; const float a0 = Y1[4 * g] * lb;
                  Y1[4 * g] = a0; Y1[4 * g + 1] = a1; Y1[4 * g + 2] = a2; Y1[4 * g + 3] = a3; }
            }
            carry = ncarry;
            v4u pa[4];
            pa[0] = (v4u){cvtpk(Y0[0], Y0[1]), cvtpk(Y0[2], Y0[3]), cvtpk(Y0[4], Y0[5]), cvtpk(Y0[6], Y0[7])};
            pa[1] = (v4u){cvtpk(Y0[8], Y0[9]), cvtpk(Y0[10], Y0[11]), cvtpk(Y0[12], Y0[13]), cvtpk(Y0[14], Y0[15])};
            pa[2] = (v4u){cvtpk(Y1[0], Y1[1]), cvtpk(Y1[2], Y1[3]), cvtpk(Y1[4], Y1[5]), cvtpk(Y1[6], Y1[7])};
            pa[3] = (v4u){cvtpk(Y1[8], Y1[9]), cvtpk(Y1[10], Y1[11]), cvtpk(Y1[12], Y1[13]), cvtpk(Y1[14], Y1[15])};
            pv64(o, Vs + vb, pa);
            if (!wave_any(carry > 1.0e-30f)) done = true;
        }
        if (lane == 0) dflag[buf * 8 + wave] = done ? 1u : 0u;
        return false;
    };
    Stage sa[2], sb[2];
#pragma unroll
    for (int j = 0; j < 2; ++j) { ld_tile(sa[j], Kg + (size_t)ktop * 64 * NPROJ + j * 64, Vg + (size_t)ktop * 64 * NPROJ + j * 64, NPROJ, wave, lane); ld_tile(sb[j], Kg + (size_t)(ktop - 1) * 64 * NPROJ + j * 64, Vg + (size_t)(ktop - 1) * 64 * NPROJ + j * 64, NPROJ, wave, lane); }
    for (int kt = ktop; kt > 0; kt -= 2) {
        if (step(sa, kt, 0)) break;
        if (step(sb, kt - 1, 1)) break;
    }
    __syncthreads();
    store_o<2>(o, (LAS float*)(lds + SB_K) + wave * 2048, AO + (row0 + q0) * 1024 + h * 64, 1024, lane);
}

constexpr int XA_K = 0, XA_V = 65536, XA_WSF = 132096;
__device__ __forceinline__ void xattn_unit(unsigned char* ws, ldsp lds, int b, int xh, int qb, int tid) {
    const int lane = tid & 63, wave = __builtin_amdgcn_readfirstlane(tid >> 6), r32 = lane & 31, hi = lane >> 5;
    const bf16* QX = (const bf16*)(ws + WS_QX); bf16* AOX = (bf16*)(ws + WS_AOX); const bf16* KV = (const bf16*)(ws + WS_MEMKV) + (size_t)b * MEMLEN_ * 1024 + xh * 128;
    LAS float* wsf = (LAS float*)(lds + XA_WSF) + wave * 32;
    __syncthreads();
#pragma unroll
    for (int i = 0; i < 8; ++i) { const int p = tid + 512 * i, c = p & 15, key = p >> 4;
        const v4u kk = *(const v4u*)(KV + (size_t)key * 1024 + c * 8), vv = *(const v4u*)(KV + (size_t)key * 1024 + 512 + c * 8);
        *(LAS v4u*)(lds + XA_K + (key >> 6) * 16384 + c * 1024 + (key & 63) * 16) = kk;
        *(LAS v4u*)(lds + XA_V + (key >> 6) * 16384 + (c >> 2) * 4096 + (key & 63) * 64 + (c & 3) * 16) = vv; }
    const size_t row0 = (size_t)b * T_; const int q0 = qb * 256 + wave * 32;
    bf16x8 qr[8];
#pragma unroll
    for (int d0 = 0; d0 < 8; ++d0) qr[d0] = *(const bf16x8*)(QX + (row0 + q0 + r32) * 512 + xh * 128 + d0 * 16 + hi * 8);
    f32x16 o[4];
#pragma unroll
    for (int db = 0; db < 4; ++db) o[db] = (f32x16){0};
    SoftState sm; sm_init(sm, 0.f); const int vb = vbase(lane);
    __syncthreads();
    for (int kt = 0; kt < 4; ++kt) {
        cldsp kb = lds + XA_K + kt * 16384 + hi * 1024 + r32 * 16; cldsp vs = lds + XA_V + kt * 16384 + vb;
        f32x16 S0 = sm_tuple(sm), S1 = S0;
#pragma unroll
        for (int d0 = 0; d0 < 8; ++d0) { const bf16x8 b0 = *(const LAS bf16x8*)(kb + d0 * 2048), b1 = *(const LAS bf16x8*)(kb + d0 * 2048 + 512);
            S0 = __builtin_amdgcn_mfma_f32_32x32x16_bf16(b0, qr[d0], S0, 0, 0, 0); S1 = __builtin_amdgcn_mfma_f32_32x32x16_bf16(b1, qr[d0], S1, 0, 0, 0); }
        v4u pa[4];
        osm_lag<4>(S0, S1, sm, kt == 0, o, wsf, r32, hi, pa);
#pragma unroll
        for (int db = 0; db < 4; ++db)
#pragma unroll
            for (int s = 0; s < 4; ++s) { const s16x4 lo = vtr(vs + db * 4096 + s * 1024), hi4 = vtr(vs + db * 4096 + s * 1024 + 512);
                const bf16x8 vf = {lo[0], lo[1], lo[2], lo[3], hi4[0], hi4[1], hi4[2], hi4[3]};
                o[db] = __builtin_amdgcn_mfma_f32_32x32x16_bf16(__builtin_bit_cast(bf16x8, pa[s]), vf, o[db], 0, 0, 0); }
    }
    { const float l = xhalf_sum(sm.l); rows_scale<4>(o, 1.0f / l, wsf, r32, hi); }
    __syncthreads();
    store_o<4>(o, (LAS float*)(lds + XA_K) + wave * 4096, AOX + (row0 + q0) * 512 + xh * 128, 512, lane);
}

constexpr int NS_K = 0, NS_V = 16384, NS_BD = 32768, NS_SLAB = 36864  , NS_SEL = 70144, NS_WSF = 70656, NS_OF = 73728;
template <int MODE> __device__ __forceinline__ void nsa_logits(f32x16& S0, f32x16& S1, int dq, int tq, int hi, const LAS float* bdh, bool sel) {
    asm volatile("" : "+v"(tq), "+v"(hi));
    if (dq < 3) {
#pragma unroll
        for (int r = 0; r < 16; ++r) { const int k = (r & 3) + 8 * (r >> 2) + 4 * hi; const unsigned d0 = (unsigned)(64 * dq + tq - k); S0[r] += bdh[d0 < 128u ? d0 : 128u]; }
#pragma unroll
        for (int r = 0; r < 16; ++r) { const int k = (r & 3) + 8 * (r >> 2) + 4 * hi; const unsigned d1 = (unsigned)(64 * dq + tq - k - 32); S1[r] += bdh[d1 < 128u ? d1 : 128u]; }
    }
    if (dq == 0) {
#pragma unroll
        for (int r = 0; r < 16; ++r) { const int k = (r & 3) + 8 * (r >> 2) + 4 * hi; if (k > tq) S0[r] = NINF; if (k + 32 > tq) S1[r] = NINF; }
    }
    if (MODE == 1 && dq == 4) {
#pragma unroll
        for (int r = 0; r < 16; ++r) { const int k = (r & 3) + 8 * (r >> 2) + 4 * hi; if (k <= tq) S0[r] = NINF; if (k + 32 <= tq) S1[r] = NINF; }
    }
}
__device__ __forceinline__ void cmp_logits(f32x16& S0, f32x16& S1, int ct, int t, int nvalid, int hi, const LAS float* bdh) {
    asm volatile("" : "+v"(t), "+v"(hi));
#pragma unroll
    for (int r = 0; r < 16; ++r) { const int c0 = 64 * ct + (r & 3) + 8 * (r >> 2) + 4 * hi; const unsigned d0 = (unsigned)(t - 31 - 16 * c0);
        const float b0 = bdh[d0 < 128u ? d0 : 128u]; S0[r] = c0 < nvalid ? S0[r] + b0 : NINF; }
#pragma unroll
    for (int r = 0; r < 16; ++r) { const int c1 = 64 * ct + 32 + (r & 3) + 8 * (r >> 2) + 4 * hi; const unsigned d1 = (unsigned)(t - 31 - 16 * c1);
        const float b1 = bdh[d1 < 128u ? d1 : 128u]; S1[r] = c1 < nvalid ? S1[r] + b1 : NINF; }
}
__device__ __forceinline__ void nsa_unit(const float* rel_bias, unsigned char* ws, ldsp lds, int b, int g, int qb, int tid) {
    const int lane = tid & 63, wave = __builtin_amdgcn_readfirstlane(tid >> 6), r32 = lane & 31, hi = lane >> 5, hj = wave >> 1, sub = wave & 1, h = g * 4 + hj;
    const bf16* PROJ = (const bf16*)(ws + WS_PROJ); bf16* AO = (bf16*)(ws + WS_AO);
    LAS float* bd = (LAS float*)(lds + NS_BD); LAS float* slab = (LAS float*)(lds + NS_SLAB); LAS unsigned* selm = (LAS unsigned*)(lds + NS_SEL); LAS float* wsf = (LAS float*)(lds + NS_WSF) + wave * 32;
    const size_t row0 = (size_t)b * T_; const int tq = sub * 32 + r32, t = qb * 64 + tq; const size_t row = row0 + t;
    __syncthreads();
    for (int i = tid; i < 4 * 130; i += NTHR) { const int rr = i / 130, dd = i % 130; const int bk = dd < 128 ? (int)T5_BUCKET[dd] : 31; const float far = rel_bias[31 * 8 + g * 4 + rr];
        bd[rr * 132 + dd] = dd < 129 ? (rel_bias[bk * 8 + g * 4 + rr] - far) * LOG2E : far * LOG2E; }
    const LAS float* bdh = bd + hj * 132;
    bf16x8 qr[4]; load_q(qr, PROJ + (row0 + qb * 64 + sub * 32) * NPROJ + EC_NQ + h * 64, NPROJ, r32, hi);
    const float* gt = (const float*)(ws + WS_GT) + row * 24 + h * 3;
    f32x16 o[2]; LAS float* ofl = (LAS float*)(lds + NS_OF) + wave * 2048;
    const int vb = vbase(lane);
    SoftState sm; float cbase;
    const int nvalid = t >= 31 ? ((t - 31) >> 4) + 1 : 0;
    const int nct = qb < 16 ? 1 : 2;
    const bf16* KCB = (const bf16*)(ws + WS_KCB) + (size_t)(b * 2 + g) * 128 * 64; const bf16* VCB = (const bf16*)(ws + WS_VCB) + (size_t)(b * 2 + g) * 128 * 64;
    { Stage st; ld_tile(st, KCB, VCB, 64, wave, lane); st_tile(st, lds + NS_K, lds + NS_V, wave, lane);
      if (nct > 1) { ld_tile(st, KCB + 64 * 64, VCB + 64 * 64, 64, wave, lane); st_tile(st, lds + NS_K + 8192, lds + NS_V + 8192, wave, lane); } }
    __syncthreads();
    cbase = bdh[129]; sm_init(sm, cbase); o[0] = (f32x16){0}; o[1] = (f32x16){0};
    for (int ct = 0; ct < nct; ++ct) {
        f32x16 S0, S1;
        S0 = sm_tuple(sm); S1 = S0; qk64(S0, S1, lds + NS_K + ct * 8192, qr, r32, hi);
        cmp_logits(S0, S1, ct, t, nvalid, hi, bdh);
        v4u pa[4]; osm_lag<2>(S0, S1, sm, ct == 0, o, wsf, r32, hi, pa);
        pv64(o, lds + NS_V + ct * 8192 + vb, pa);
    }
    const float lc = xhalf_sum(sm.l);
    const float il = lc > 0.f ? 1.0f / lc : 0.f;
    rows_fma<true>(ofl, o, gt[0] * il, wsf, r32, hi, lane);
    { float carry = 0.f;
      for (int ct = 0; ct < nct; ++ct) {
        f32x16 S0 = sm_tuple(sm), S1 = S0;
        qk64(S0, S1, lds + NS_K + ct * 8192, qr, r32, hi);
        cmp_logits(S0, S1, ct, t, nvalid, hi, bdh);
#pragma unroll
        for (int r = 0; r < 16; ++r) { S0[r] = __builtin_amdgcn_exp2f(S0[r]) * il; S1[r] = __builtin_amdgcn_exp2f(S1[r]) * il; }
        float lo0[4], hi0[4], lo1[4], hi1[4];
#pragma unroll
        for (int gq = 0; gq < 4; ++gq) { auto r0 = __builtin_amdgcn_permlane32_swap(__float_as_uint(S0[4 * gq + 3]), __float_as_uint(S0[4 * gq + 3]), false, false); auto r1 = __builtin_amdgcn_permlane32_swap(__float_as_uint(S1[4 * gq + 3]), __float_as_uint(S1[4 * gq + 3]), false, false);
            lo0[gq] = __uint_as_float(r0[0]); hi0[gq] = __uint_as_float(r0[1]); lo1[gq] = __uint_as_float(r1[0]); hi1[gq] = __uint_as_float(r1[1]); }
        LAS float* sl = slab + (hj * 32 + ct * 16) * 65 + tq;
#pragma unroll
        for (int gq = 0; gq < 4; ++gq) {
            const float s0 = (S0[4 * gq] + S0[4 * gq + 1]) + (S0[4 * gq + 2] + S0[4 * gq + 3]), s1 = (S1[4 * gq] + S1[4 * gq + 1]) + (S1[4 * gq + 2] + S1[4 * gq + 3]);
            const float pv0 = hi ? lo0[gq] : (gq == 0 ? carry : hi0[gq > 0 ? gq - 1 : 0]);
            const float pv1 = hi ? lo1[gq] : (gq == 0 ? hi0[3] : hi1[gq > 0 ? gq - 1 : 0]);
            sl[(2 * gq + hi) * 65] = s0 + pv0; sl[(8 + 2 * gq + hi) * 65] = s1 + pv1; }
        carry = hi1[3];
      } }
    __syncthreads();
    {
      const int ql = tid >> 3, j8 = tid & 7; float sc[4];
#pragma unroll
      for (int i = 0; i < 4; ++i) { const int n = 4 * j8 + i; const float v = (slab[(0 * 32 + n) * 65 + ql] + slab[(1 * 32 + n) * 65 + ql]) + (slab[(2 * 32 + n) * 65 + ql] + slab[(3 * 32 + n) * 65 + ql]);
          sc[i] = (n > qb) ? -1.0f : ((n == 0 || n == qb || n == qb - 1) ? 1.0e4f : v); }
      unsigned msk = 0u;
#pragma unroll 1
      for (int k = 0; k < 8; ++k) {
          float bv = sc[0]; int bi = 4 * j8;
#pragma unroll
          for (int i = 1; i < 4; ++i) if (sc[i] > bv) { bv = sc[i]; bi = 4 * j8 + i; }
          { float ov = lane_dpp<DPP_XOR1>(bv); int oi = lane_dpp_i<DPP_XOR1>(bi); if (ov > bv || (ov == bv && oi < bi)) { bv = ov; bi = oi; }
            ov = lane_dpp<DPP_XOR2>(bv); oi = lane_dpp_i<DPP_XOR2>(bi); if (ov > bv || (ov == bv && oi < bi)) { bv = ov; bi = oi; }
            ov = lane_dpp<DPP_HALF_MIRROR>(bv); oi = lane_dpp_i<DPP_HALF_MIRROR>(bi); if (ov > bv || (ov == bv && oi < bi)) { bv = ov; bi = oi; } }
#pragma unroll
          for (int i = 0; i < 4; ++i) if (bi == 4 * j8 + i) sc[i] = -3.0e38f;
          msk |= 1u << bi; }
      if (j8 == 0) selm[ql] = msk; }
    __syncthreads();
    const unsigned mask = selm[tq];
    { const bf16* Kg = PROJ + row0 * NPROJ + EC_KSL + g * 64; const bf16* Vg = PROJ + row0 * NPROJ + EC_VSL + g * 64;
      sm_init(sm, cbase); o[0] = (f32x16){0}; o[1] = (f32x16){0};
      auto step = [&](Stage& st, int n) __attribute__((always_inline)) {
        ldsp Ks = lds + NS_K + (n & 1) * 8192; ldsp Vs = lds + NS_V + (n & 1) * 8192;
        st_tile(st, Ks, Vs, wave, lane);
        __syncthreads();
        if (n + 1 <= qb) ld_tile(st, Kg + (size_t)(n + 1) * 64 * NPROJ, Vg + (size_t)(n + 1) * 64 * NPROJ, NPROJ, wave, lane);
        const bool sel = (mask >> n) & 1u;
        if (wave_any(sel)) {
            f32x16 S0, S1;
            S0 = sm_tuple(sm); S1 = S0; qk64(S0, S1, Ks, qr, r32, hi);
            nsa_logits<0>(S0, S1, qb - n, tq, hi, bdh, sel);
            v4u pa[4]; osm_lag<2>(S0, S1, sm, n == 0, o, wsf, r32, hi, pa, sel);
            pv64(o, Vs + vb, pa);
        }
      };
      Stage sa; ld_tile(sa, Kg, Vg, NPROJ, wave, lane);
#pragma unroll 1
      for (int n = 0; n <= qb; ++n) step(sa, n);
      rows_fma<false>(ofl, o, gt[1] / xhalf_sum(sm.l), wsf, r32, hi, lane); }
    { const bf16* Kg = PROJ + row0 * NPROJ + EC_KWN + g * 64; const bf16* Vg = PROJ + row0 * NPROJ + EC_VWN + g * 64;
      o[0] = (f32x16){0}; o[1] = (f32x16){0};
      const int n0 = qb > 4 ? qb - 4 : 0;
      __syncthreads();
      sm_init(sm, cbase);
      auto step = [&](Stage& st, int n) __attribute__((always_inline)) {
        ldsp Ks = lds + NS_K + (n & 1) * 8192; ldsp Vs = lds + NS_V + (n & 1) * 8192;
        st_tile(st, Ks, Vs, wave, lane);
        __syncthreads();
        if (n + 1 <= qb) ld_tile(st, Kg + (size_t)(n + 1) * 64 * NPROJ, Vg + (size_t)(n + 1) * 64 * NPROJ, NPROJ, wave, lane);
        f32x16 S0, S1;
        S0 = sm_tuple(sm); S1 = S0; qk64(S0, S1, Ks, qr, r32, hi);
        nsa_logits<1>(S0, S1, qb - n, tq, hi, bdh, true);
        v4u pa[4]; osm_lag<2>(S0, S1, sm, n == n0, o, wsf, r32, hi, pa);
        pv64(o, Vs + vb, pa);
      };
      Stage sa; ld_tile(sa, Kg + (size_t)n0 * 64 * NPROJ, Vg + (size_t)n0 * 64 * NPROJ, NPROJ, wave, lane);
#pragma unroll 1
      for (int n = n0; n <= qb; ++n) step(sa, n);
      rows_fma<false>(ofl, o, gt[2] / xhalf_sum(sm.l), wsf, r32, hi, lane); }
    asm volatile("s_waitcnt lgkmcnt(0)" ::: "memory");
    emit_o<2>(ofl, AO + (row0 + qb * 64 + sub * 32) * 1024 + 512 + h * 64, 1024, lane);
}

constexpr int CP_PART = 0, CP_H = 32768;
__device__ __forceinline__ void compress_unit(unsigned char* ws, ldsp lds, int b, int g, int kv, int rb, int e2, int tid) {
    const int lane = tid & 63, wave = __builtin_amdgcn_readfirstlane(tid >> 6), r32 = lane & 31, hi = lane >> 5, cb = wave & 1, kq = wave >> 1, mi = e2 * 2 + kv;
    const bf16* X = (const bf16*)(ws + WS_PROJ) + (size_t)b * T_ * NPROJ + (kv ? EC_VC : EC_KC) + g * 64;
    const bf16* W1t = (const bf16*)(ws + WS_CW1) + (size_t)mi * 64 * 2048; const bf16* W2t = (const bf16*)(ws + WS_CW2) + (size_t)mi * 64 * 64; const float* b1 = (const float*)(ws + WS_CB1) + mi * 64;
    bf16* OUTB = (bf16*)(ws + (kv ? WS_VCB : WS_KCB)) + (size_t)(b * 2 + g) * 128 * 64; float* OUTF = (float*)(ws + (kv ? WS_VC : WS_KC)) + (size_t)(b * 2 + g) * 127 * 64;
    LAS float* part = (LAS float*)(lds + CP_PART);
    LAS unsigned short* H = (LAS unsigned short*)(lds + CP_H);
    __syncthreads();
    const int c = rb * 32 + r32;
    f32x16 acc = (f32x16){0};
    const bf16* wrow = W1t + (size_t)(cb * 32 + r32) * 2048 + hi * 8;
#pragma unroll 8
    for (int k8 = 0; k8 < 32; ++k8) { const int ks = kq * 32 + k8, l = ks >> 2, d = (ks & 3) * 16 + hi * 8; int xr = 16 * c + l; xr = xr < 2047 ? xr : 2047;
        const bf16x8 af = *(const bf16x8*)(X + (size_t)xr * NPROJ + d); const bf16x8 bfr = *(const bf16x8*)(wrow + ks * 16);
        acc = __builtin_amdgcn_mfma_f32_32x32x16_bf16(af, bfr, acc, 0, 0, 0); }
#pragma unroll
    for (int r = 0; r < 16; ++r) part[((kq * 2 + cb) * 16 + r) * 64 + lane] = acc[r];
    __syncthreads();
    if (kq == 0) { const float bb = b1[cb * 32 + r32];
#pragma unroll
      for (int r = 0; r < 16; ++r) { const int cr = (r & 3) + 8 * (r >> 2) + 4 * hi;
          const float x = ((part[((0 * 2 + cb) * 16 + r) * 64 + lane] + part[((1 * 2 + cb) * 16 + r) * 64 + lane]) + (part[((2 * 2 + cb) * 16 + r) * 64 + lane] + part[((3 * 2 + cb) * 16 + r) * 64 + lane])) + bb;
          const float u2 = 0.7978845608028654f * (x + 0.044715f * x * x * x); const float hg = x * __builtin_amdgcn_rcpf(1.0f + __builtin_amdgcn_exp2f(-2.0f * LOG2E * u2)); H[cr * 64 + cb * 32 + r32] = (unsigned short)f2bf(hg); } }
    __syncthreads();
    if (kq == 0) {
        f32x16 acc2 = (f32x16){0};
#pragma unroll
        for (int ks = 0; ks < 4; ++ks) { const bf16x8 af = *(const LAS bf16x8*)(H + r32 * 64 + ks * 16 + hi * 8); const bf16x8 bfr = *(const bf16x8*)(W2t + (size_t)(cb * 32 + r32) * 64 + ks * 16 + hi * 8);
            acc2 = __builtin_amdgcn_mfma_f32_32x32x16_bf16(af, bfr, acc2, 0, 0, 0); }
#pragma unroll
        for (int r = 0; r < 16; ++r) { const int cr = rb * 32 + (r & 3) + 8 * (r >> 2) + 4 * hi; const float v = cr < 127 ? acc2[r] : 0.f;
            OUTB[(size_t)cr * 64 + cb * 32 + r32] = (bf16)f2bf(v); if (cr < 127) OUTF[(size_t)cr * 64 + cb * 32 + r32] = v; }
    }
}
static_assert(NS_OF + 65536 <= LDSCTL_OFF && SB_FLAG + 64 <= LDSCTL_OFF && XA_WSF + 1024 <= LDSCTL_OFF && FX_WSF + 1024 <= LDSCTL_OFF, "phase scratch below the barrier words");
}
constexpr int NPHASE = 2 + 9 * DEPTH_;
__host__ __device__ inline bool phase_empty(int ph) { if (ph == 0 || ph == NPHASE - 1) return false; const int l = (ph - 1) / 9, j = (ph - 1) % 9; return (j == 2) && (l & 1); }

struct GemmJob { int type; pg8::Gemm g; int cshift; pg8::bf16_t* O; int ldc; const float* ss; };

__device__ __forceinline__ GemmJob make_job(unsigned char* ws, float* X, int l, int j, int jb) {
    bf16* const XB = (bf16*)(ws + WS_XB); float* const SS = (float*)(ws + WS_SS); const bool even = (l & 1) == 0;
    if (j == 0) return GemmJob{even ? 0 : 1, pg8::Gemm{XB, (const bf16*)(ws + WS_WIN) + (size_t)l * NPROJ * 1024, M_, NPROJ, 1024}, 0, (bf16*)(ws + WS_PROJ), NPROJ, SS};
    if (j == 3) return GemmJob{3, pg8::Gemm{(const bf16*)(ws + WS_AO), (const bf16*)(ws + WS_WOUT) + (size_t)l * 1024 * 1024, M_, 1024, 1024}, 0, nullptr, 0, nullptr};
    if (j == 4) { if (jb == 0) return GemmJob{1, pg8::Gemm{XB, (const bf16*)(ws + WS_WQ) + (size_t)l * 512 * 1024, M_, 512, 1024}, 0, (bf16*)(ws + WS_QX), 512, SS};
                  return GemmJob{1, pg8::Gemm{(const bf16*)(ws + WS_MEMN), (const bf16*)(ws + WS_WKV) + (size_t)l * 1024 * 1024, MM_, 1024, 1024}, 128, (bf16*)(ws + WS_MEMKV), 1024, nullptr}; }
    if (j == 6) return GemmJob{3, pg8::Gemm{(const bf16*)(ws + WS_AOX), (const bf16*)(ws + WS_WO) + (size_t)l * 1024 * 512, M_, 1024, 512}, 0, nullptr, 0, nullptr};
    if (j == 7) return GemmJob{2, pg8::Gemm{XB, (const bf16*)(ws + WS_W1) + (size_t)l * 4096 * 1024, M_, FF_, 1024}, 0, (bf16*)(ws + WS_H), FF_, SS};
    return GemmJob{3, pg8::Gemm{(const bf16*)(ws + WS_H), (const bf16*)(ws + WS_W2) + (size_t)l * 1024 * 4096, M_, 1024, FF_}, 0, nullptr, 0, nullptr};
}

#define HAS(k) (PT < 0 || PT == (k))
template <int PT> __global__ void __launch_bounds__(NTHR, 2) fwd_kernel(Args args) {
    extern __shared__ __attribute__((aligned(16))) unsigned char lds_raw[];
    LAS unsigned char* lds = (LAS unsigned char*)lds_raw;
    volatile LAS unsigned* MISC = (volatile LAS unsigned*)(lds + MISC_OFF);
    const int tid0 = threadIdx.x;
    Frame F; F.lds = lds; F.tid = tid0; F.lane = tid0 & 63; F.wave = __builtin_amdgcn_readfirstlane(tid0 >> 6); F.G = gridDim.x;
    { const int bx = blockIdx.x; F.vcu = (F.G % 8 == 0) ? (bx % 8) * (F.G / 8) + bx / 8 : bx; }
    F.ws = args.ws;
    unsigned char* ws = args.ws; gu32* ctl = (gu32*)(ws + WS_CTL);
    for (int u = tid0; u < (LDS_BYTES - LDSCTL_OFF) / 4; u += NTHR) ((LAS unsigned*)(lds + LDSCTL_OFF))[u] = 0u;
    __syncthreads();
    const int lo = args.ph_lo, hi = args.ph_hi;
    int nne = 0; for (int p = lo; p < hi; ++p) nne += phase_empty(p) ? 0 : 1;
    XcdBarrier bar; bar.bar = (unsigned*)(ctl + CW_BAR); bar.x = 0; bar.st = nullptr;
    if (nne > 1) bar = xcd_barrier_post((unsigned*)(ctl + CW_BAR), MISC + 8);
    bool ran = false;
#if defined(PROBE_A)
    unsigned long long pr_t = __builtin_amdgcn_s_memrealtime(), pr_da = 0, pr_db = 0; int pr_last = (args.ph_lo == 0) ? 0 : -1;
#endif
    float* const X = args.out; bf16* const XB = (bf16*)(ws + WS_XB); float* const SS = (float*)(ws + WS_SS);
#if defined(PROBE_DELAY)
    { const unsigned long long t0_ = __builtin_amdgcn_s_memrealtime(); while (__builtin_amdgcn_s_memrealtime() - t0_ < PROBE_DELAY * 100ull) __builtin_amdgcn_s_sleep(8); }
#endif
    if (lo == 0) { if constexpr (HAS(0)) { int tid = threadIdx.x; asm volatile("" : "+v"(tid)); F.tid = tid; F.lane = tid & 63; F.wave = __builtin_amdgcn_readfirstlane(tid >> 6); p0_prologue(F, args);
#if defined(PROBE_PRO2)
        p0_prologue(F, args);
#endif
        } ran = true; }
    const int loop_lo = lo < 1 ? 1 : lo, loop_hi = hi < NPHASE - 1 ? hi : NPHASE - 1;
    for (int ph = loop_lo; ph < loop_hi; ++ph) {
        if (phase_empty(ph)) continue;
        if (ran) xcd_barrier(bar);
        ran = true;
#if defined(PROBE_A)
        { const unsigned long long now_ = __builtin_amdgcn_s_memrealtime(); if (pr_last == PROBE_A) pr_da = now_ - pr_t; if (pr_last == PROBE_B) pr_db = now_ - pr_t; pr_t = now_; pr_last = ph; }
#endif
        int tid = threadIdx.x; asm volatile("" : "+v"(tid));
        F.tid = tid; F.lane = tid & 63; F.wave = __builtin_amdgcn_readfirstlane(tid >> 6);
        const int l = (ph - 1) / 9, j = (ph - 1) % 9; const bool even = (l & 1) == 0;
        const int njobs = (j == 0 || j == 3 || j == 6 || j == 7 || j == 8) ? 1 : (j == 4 ? 2 : 0);
        for (int jb = 0; jb < njobs; ++jb) {
            const GemmJob J = make_job(ws, args.out, l, j, jb);
            pg8::StaticOrder S; S.init(J.g.M, J.g.N, F.G, (int)((blockIdx.x + F.G - J.cshift) % F.G));
            float* const LF = (float*)(ws + WS_LF); float* const GT = (float*)(ws + WS_GT); const float* bfg = args.b_forget + (l >> 1) * 8;
            if (J.type == 0) { if constexpr (HAS(1)) { pg8::EpiBf<0, true> E{J.O, J.ldc, J.ss, LF, GT, bfg}; pg8::gemm_phase<pg8::EpiBf<0, true>, pg8::StaticOrder, true, true>(lds + RING_OFF, J.g, S, E); } }
            else if (J.type == 1) { if constexpr (HAS(2)) { pg8::EpiBf<0, false> E{J.O, J.ldc, J.ss, nullptr, nullptr, nullptr}; pg8::gemm_phase<pg8::EpiBf<0, false>, pg8::StaticOrder, true, true>(lds + RING_OFF, J.g, S, E); } }
            else if (J.type == 2) { if constexpr (HAS(3)) { pg8::EpiBf<1, false> E{J.O, J.ldc, J.ss, nullptr, nullptr, nullptr}; pg8::gemm_phase<pg8::EpiBf<1, false>, pg8::StaticOrder, true, true>(lds + RING_OFF, J.g, S, E); } }
            else { if constexpr (HAS(4)) { pg8::EpiResid E{(l == 0 && j == 3) ? args.x : (const float*)nullptr, (l == DEPTH_ - 1 && j == 8) ? X : (float*)nullptr, XB, SS}; pg8::gemm_phase<pg8::EpiResid, pg8::StaticOrder, false, true>(lds + RING_OFF, J.g, S, E); } }
        }
        if (j == 4 && l + 1 < DEPTH_ && blockIdx.x >= 160) { if constexpr (HAS(2)) convert_layer_weights(F, args, l + 1, ((int)blockIdx.x - 160) * NWAVES + F.wave, ((int)F.G - 160) * NWAVES); }
        if (j == 1) {
            if (even) { if constexpr (HAS(5)) {
#if USE_MFMA_FOX
                for (int u = blockIdx.x; u < 512; u += F.G) { const int c = u & 255, i = u >> 8, s = c & 3; at::fox_unit(ws, lds, c >> 5, (c >> 2) & 7, i ? 7 - s : s, tid); }
#else
                for (int u = blockIdx.x; u < 256; u += F.G) fox_naive_unit(ws, lds, u, tid);
#endif
#if USE_MFMA_CMP
                for (int u = blockIdx.x; u < 128; u += F.G) at::compress_unit(ws, lds, u >> 4, (u >> 3) & 1, (u >> 2) & 1, u & 3, l >> 1, tid);
#else
                for (int u = blockIdx.x; u < 256; u += F.G) compress_naive_unit(args, ws, lds, u, l, tid);
#endif
            } }
            else { if constexpr (HAS(6)) {
#if USE_MFMA_SB
                for (int u = blockIdx.x; u < 1024; u += F.G) at::sb_unit(ws, lds, u >> 7, (u >> 4) & 7, 15 - (u & 15), tid);
#else
                for (int u = blockIdx.x; u < 512; u += F.G) sb_naive_unit(ws, lds, u, tid);
#endif
            } }
        } else if (j == 2) { if constexpr (HAS(7)) {
#if USE_MFMA_NSA
            for (int u = blockIdx.x; u < 512; u += F.G) { const int c = u & 255, i = u >> 8, s = c & 15; at::nsa_unit(args.rel_bias, ws, lds, c >> 5, (c >> 4) & 1, i ? 31 - s : s, tid); }
#else
            for (int u = blockIdx.x; u < 256; u += F.G) nsa_naive_unit(args, ws, lds, u, tid);
#endif
        } }
        else if (j == 5) { if constexpr (HAS(8)) {
#if USE_MFMA_XA
            for (int u = blockIdx.x; u < 256; u += F.G) at::xattn_unit(ws, lds, u >> 5, (u >> 3) & 3, u & 7, tid);
#else
            for (int u = blockIdx.x; u < 256; u += F.G) xattn_naive_unit(ws, lds, u, tid);
#endif
        } }
    }
    if (hi == NPHASE) { if (ran) xcd_barrier(bar);
        if constexpr (HAS(9)) { int tid = threadIdx.x; asm volatile("" : "+v"(tid)); F.tid = tid; F.lane = tid & 63; F.wave = __builtin_amdgcn_readfirstlane(tid >> 6); final_norm(F, args); } }
#if defined(PROBE_BARRIERS)
    for (int i = 0; i < PROBE_BARRIERS; ++i) xcd_barrier(bar);
#endif
#if defined(SUBPROBE)
    if (blockIdx.x == 0) { LAS unsigned long long* acc = (LAS unsigned long long*)(lds + LDSCTL_OFF); __syncthreads();
        unsigned long long qa = (acc[SUB_A] + SUB_Q / 2) / SUB_Q, qb2 = (acc[SUB_B] + SUB_Q / 2) / SUB_Q; if (qa > 63) qa = 63; if (qb2 > 63) qb2 = 63;
        const unsigned long long target = __builtin_amdgcn_s_memrealtime() + 4000ull * (qa + 64ull * qb2);
        while (__builtin_amdgcn_s_memrealtime() < target) __builtin_amdgcn_s_sleep(32); }
#endif
#if defined(PROBE_A)
    { const unsigned long long now_ = __builtin_amdgcn_s_memrealtime(); if (pr_last == PROBE_A) pr_da = now_ - pr_t; if (pr_last == PROBE_B) pr_db = now_ - pr_t;
      if (blockIdx.x == 0) { unsigned long long qa = (pr_da + 400) / 800, qb2 = (pr_db + 400) / 800; if (qa > 63) qa = 63; if (qb2 > 63) qb2 = 63;
          const unsigned long long target = now_ + 4000ull * (qa + 64ull * qb2);
          while (__builtin_amdgcn_s_memrealtime() < target) __builtin_amdgcn_s_sleep(32); } }
#endif
}

#ifndef MK_SINGLE
#define MK_SINGLE 0
#endif
#if MK_SINGLE
constexpr int NKERN = 1;
static const void* kern_ptr(int) { return (const void*)fwd_kernel<-1>; }
#else
constexpr int NKERN = 10;
static const void* kern_ptr(int k) {
    switch (k) { case 0: return (const void*)fwd_kernel<0>; case 1: return (const void*)fwd_kernel<1>; case 2: return (const void*)fwd_kernel<2>; case 3: return (const void*)fwd_kernel<3>; case 4: return (const void*)fwd_kernel<4>;
                 case 5: return (const void*)fwd_kernel<5>; case 6: return (const void*)fwd_kernel<6>; case 7: return (const void*)fwd_kernel<7>; case 8: return (const void*)fwd_kernel<8>; default: return (const void*)fwd_kernel<9>; }
}
static int phase_kernel(int ph) {
    if (ph == 0) return 0; if (ph == NPHASE - 1) return 9;
    const int l = (ph - 1) / 9, j = (ph - 1) % 9; const bool even = (l & 1) == 0;
    switch (j) { case 0: return even ? 1 : 2; case 1: return even ? 5 : 6; case 2: return 7; case 3: return 4; case 4: return 2; case 5: return 8; case 6: return 4; case 7: return 3; default: return 4; }
}
#endif
extern "C" void kernel_launch(void* const* d_in, const int* in_sizes, int n_in, void* d_out, int out_size, void* d_ws, size_t ws_size, hipStream_t stream) {
    static int grid = 0;
    if (grid == 0) {
        if (n_in != 24 || in_sizes[0] != M_ * D_ || out_size != M_ * D_ || ws_size < WS_END) { fprintf(stderr, "kernel_launch: unexpected problem (n_in %d, ws %zu); nothing launched\n", n_in, ws_size); grid = -1; return; }
        int dev = 0, cus = 0;
        if (hipGetDevice(&dev) != hipSuccess || hipDeviceGetAttribute(&cus, hipDeviceAttributeMultiprocessorCount, dev) != hipSuccess) { grid = -1; return; }
        for (int k = 0; k < NKERN; ++k) if (hipFuncSetAttribute(kern_ptr(k), hipFuncAttributeMaxDynamicSharedMemorySize, LDS_BYTES) != hipSuccess) { fprintf(stderr, "kernel_launch: hipFuncSetAttribute failed\n"); grid = -1; return; }
        (void)hipGetLastError();
        grid = cus;
    }
    if (grid < 0) return;
    (void)hipMemsetAsync((char*)d_ws + WS_CTL, 0, CTL_ZERO_BYTES, stream);
    Args a{};
    const float** ap = (const float**)&a;
    for (int i = 0; i < 24; ++i) ap[i] = (const float*)d_in[i];
    a.out = (float*)d_out; a.ws = (unsigned char*)d_ws;
#if MK_SINGLE
    a.ph_lo = 0; a.ph_hi = NPHASE;
    hipLaunchKernelGGL(fwd_kernel<-1>, dim3(grid), dim3(NTHR), LDS_BYTES, stream, a);
#else
    for (int ph = 0; ph < NPHASE; ++ph) { if (phase_empty(ph)) continue; a.ph_lo = ph; a.ph_hi = ph + 1; void* kargs[] = {&a};
        (void)hipLaunchKernel(kern_ptr(phase_kernel(ph)), dim3(grid), dim3(NTHR), kargs, LDS_BYTES, stream); }
#endif
}
```

```cpp
#include <hip/hip_runtime.h>
#include <cstdio>
#include <cstdint>
#include <cmath>
#define MK_SINGLE 1
#ifndef MK_SINGLE
#define MK_SINGLE 0
#endif
#ifndef USE_MFMA_FOX
#define USE_MFMA_FOX 1
#endif
#ifndef USE_MFMA_SB
#define USE_MFMA_SB 1
#endif
#ifndef USE_MFMA_XA
#define USE_MFMA_XA 1
#endif
#ifndef USE_MFMA_NSA
#define USE_MFMA_NSA 1
#endif
#ifndef USE_MFMA_CMP
#define USE_MFMA_CMP 1
#endif
namespace pg8 {
#define PG8_LAS __attribute__((address_space(3)))
typedef unsigned short bf16_t;
typedef short bf16x8 __attribute__((ext_vector_type(8)));
typedef float f32x4 __attribute__((ext_vector_type(4)));
typedef unsigned u32x4 __attribute__((ext_vector_type(4)));
constexpr int BM = 256, BK = 64, HALF = 128, HTB = HALF * BK * 2  , STAGE_BYTES = 8 * HTB, NXCD = 8, WGM = 8;

__host__ __device__ __forceinline__ int lds_byte(int r, int c) { const int st = (r >> 4) * 2 + (c >> 5), rr = r & 15, cc = c & 31, ob = rr * 64 + cc * 2; return st * 1024 + (ob ^ (((ob >> 9) & 1) << 5)); }
__host__ __device__ __forceinline__ void stage_rc(int b, int& R, int& C) { const int st = b / 1024, sb = b % 1024, swz = sb ^ (((sb >> 9) & 1) << 5); R = (st >> 1) * 16 + swz / 64; C = (st & 1) * 32 + (swz % 64) / 2; }
__host__ __device__ __forceinline__ int perm32(int rho) { const int n = rho >> 4, i = rho & 15; return 8 * (i >> 2) + 4 * n + (i & 3); }

struct Unit { int pm, pn; };
struct Gemm { const bf16_t* A; const bf16_t* Bt; int M, N, K; };

struct StaticOrder {
    int nM, nN, nwg, G, c;
    __host__ __device__ void init(int M, int N, int G_, int c_) { nM = M / BM; nN = N / BM; nwg = nM * nN; G = G_; c = c_; }
    __host__ __device__ bool next(int i, Unit& u) const {
        const long L = (long)i * G + c; if (L >= nwg) return false;
        int wgid = (int)L; { const int q = nwg / NXCD, r = nwg % NXCD, xcd = wgid % NXCD, off = wgid / NXCD; wgid = (xcd < r ? xcd * (q + 1) : r * (q + 1) + (xcd - r) * q) + off; }
        const int nig = WGM * nN, gid = wgid / nig, fm = gid * WGM, gsz = (nM - fm) < WGM ? (nM - fm) : WGM;
        u.pm = fm + ((wgid % nig) % gsz); u.pn = (wgid % nig) / gsz; return true;
    }
    __device__ __forceinline__ void a_ready(const Unit&) const {}
    __device__ __forceinline__ void done(const Unit&) const {}
};
__device__ __forceinline__ unsigned cvt_pk_bf16(float lo, float hi) { unsigned r; asm volatile("v_cvt_pk_bf16_f32 %0, %1, %2" : "=v"(r) : "v"(lo), "v"(hi)); return r; }
typedef float f32x2 __attribute__((ext_vector_type(2)));
constexpr float RMS_EPS = 1e-6f, LOG2E_F = 1.4426950408889634f;
__device__ __forceinline__ void store16_wt(void* p, u32x4 v) { asm volatile("global_store_dwordx4 %0, %1, off sc1\n\ts_nop 1" :: "v"(p), "v"(v) : "memory"); }
typedef unsigned u32x2e __attribute__((ext_vector_type(2)));
__device__ __forceinline__ void store8_wt(void* p, u32x2e v) { asm volatile("global_store_dwordx2 %0, %1, off sc1\n\ts_nop 1" :: "v"(p), "v"(v) : "memory"); }
__device__ __forceinline__ float row_rs(const float* ss, int row) {
    const f32x4* p = (const f32x4*)(ss + (size_t)row * 16);
    const f32x4 a = p[0], b = p[1], c = p[2], d = p[3];
    const float s = ((a[0] + a[1]) + (a[2] + a[3])) + ((b[0] + b[1]) + (b[2] + b[3])) + ((c[0] + c[1]) + (c[2] + c[3])) + ((d[0] + d[1]) + (d[2] + d[3]));
    return __builtin_amdgcn_rsqf(s * (1.0f / 1024.0f) + RMS_EPS);
}
template <int ACT, bool SPECIAL> struct EpiBf {
    static constexpr bool PERM = true, AFTER_DRAIN = false, INIT_ACC = false, PREP = true;
    bf16_t* O; int ldc; const float* ss; float* LF; float* GT; const float* bforget;
    __device__ __forceinline__ void prep(const Unit& u, PG8_LAS float* rbuf, int tid) const { if (tid < BM) rbuf[tid] = ss ? row_rs(ss, u.pm * BM + tid) : 1.0f; }
    __device__ __forceinline__ void epi(const f32x4 (&acc)[2][2][4][2], const Unit& u, int wr, int wc, int fr, int fq, const PG8_LAS float* rbuf) const {
        const int row0 = u.pm * BM + wr * 64 + fr;
        if (SPECIAL && u.pn == 11) {
            if (wc != 0) return;
#pragma unroll
            for (int ai = 0; ai < 2; ++ai)
#pragma unroll
                for (int m = 0; m < 4; ++m) {
                    const int row = row0 + ai * HALF + m * 16; const float r = rbuf[row - u.pm * BM];
                    const f32x4 v0 = acc[ai][0][m][0] * r, v1 = acc[ai][0][m][1] * r;
                    const float v[8] = {v0[0], v0[1], v0[2], v0[3], v1[0], v1[1], v1[2], v1[3]};
                    if (fq == 0) { const int b = row >> 11, t = row & 2047;
#pragma unroll
                        for (int j = 0; j < 8; ++j) { const float x2 = (v[j] + bforget[j]) * LOG2E_F;
                            LF[(size_t)(b * 8 + j) * 2048 + t] = fminf(x2, 0.f) - __builtin_amdgcn_logf(1.0f + __builtin_amdgcn_exp2f(-fabsf(x2))); }
                    } else {
#pragma unroll
                        for (int j = 0; j < 8; ++j) GT[(size_t)row * 24 + 8 * (fq - 1) + j] = __builtin_amdgcn_rcpf(1.0f + __builtin_amdgcn_exp2f(-v[j] * LOG2E_F));
                    }
                }
            return;
        }
        const int col0 = u.pn * BM + wc * 32 + 8 * fq;
#pragma unroll
        for (int ai = 0; ai < 2; ++ai)
#pragma unroll
            for (int m = 0; m < 4; ++m) { const int row = row0 + ai * HALF + m * 16; const float r = rbuf[row - u.pm * BM]; bf16_t* rowp = O + (size_t)row * ldc + col0;
#pragma unroll
                for (int bj = 0; bj < 2; ++bj) { f32x4 v0 = acc[ai][bj][m][0] * r, v1 = acc[ai][bj][m][1] * r;
                    if (ACT == 1) {
#pragma unroll
                        for (int i = 0; i < 4; ++i) { const float a = fmaxf(v0[i], 0.f), b = fmaxf(v1[i], 0.f); v0[i] = a * a; v1[i] = b * b; } }
                    u32x4 w; w.x = cvt_pk_bf16(v0[0], v0[1]); w.y = cvt_pk_bf16(v0[2], v0[3]); w.z = cvt_pk_bf16(v1[0], v1[1]); w.w = cvt_pk_bf16(v1[2], v1[3]);
                    *(u32x4*)(rowp + bj * HALF) = w; } }
    }
};
struct EpiResid {
    static constexpr bool PERM = true, AFTER_DRAIN = false, INIT_ACC = true, PREP = false;
    const float* Xin; float* Xout; bf16_t* XB; float* SS;
    __device__ __forceinline__ void init(f32x4 (&acc)[2][2][4][2], const Unit& u, int wr, int wc, int fr, int fq) const {
        const int row0 = u.pm * BM + wr * 64 + fr, col0 = u.pn * BM + wc * 32 + 8 * fq;
        if (Xin) {
#pragma unroll
        for (int ai = 0; ai < 2; ++ai)
#pragma unroll
            for (int m = 0; m < 4; ++m) { const size_t off = (size_t)(row0 + ai * HALF + m * 16) * 1024 + col0;
#pragma unroll
                for (int bj = 0; bj < 2; ++bj)
#pragma unroll
                    for (int n = 0; n < 2; ++n) acc[ai][bj][m][n] = *(const f32x4*)(Xin + off + bj * HALF + n * 4); }
        } else {
        u32x4 w[2][2][4];
#pragma unroll
        for (int ai = 0; ai < 2; ++ai)
#pragma unroll
            for (int m = 0; m < 4; ++m) { const size_t off = (size_t)(row0 + ai * HALF + m * 16) * 1024 + col0;
#pragma unroll
                for (int bj = 0; bj < 2; ++bj) w[ai][bj][m] = *(const u32x4*)(XB + off + bj * HALF); }
#pragma unroll
        for (int ai = 0; ai < 2; ++ai)
#pragma unroll
            for (int m = 0; m < 4; ++m)
#pragma unroll
                for (int bj = 0; bj < 2; ++bj) { const u32x4 x = w[ai][bj][m];
                    acc[ai][bj][m][0] = (f32x4){__builtin_bit_cast(float, x.x << 16), __builtin_bit_cast(float, x.x & 0xffff0000u), __builtin_bit_cast(float, x.y << 16), __builtin_bit_cast(float, x.y & 0xffff0000u)};
                    acc[ai][bj][m][1] = (f32x4){__builtin_bit_cast(float, x.z << 16), __builtin_bit_cast(float, x.z & 0xffff0000u), __builtin_bit_cast(float, x.w << 16), __builtin_bit_cast(float, x.w & 0xffff0000u)}; }
        }
    }
    __device__ __forceinline__ void operator()(const f32x4 (&acc)[2][2][4][2], const Unit& u, int wr, int wc, int fr, int fq) const {
        const int row0 = u.pm * BM + wr * 64 + fr, col0 = u.pn * BM + wc * 32 + 8 * fq;
#pragma unroll
        for (int ai = 0; ai < 2; ++ai)
#pragma unroll
            for (int m = 0; m < 4; ++m) { const int row = row0 + ai * HALF + m * 16; const size_t off = (size_t)row * 1024 + col0; float sq = 0.f;
#pragma unroll
                for (int bj = 0; bj < 2; ++bj) { const f32x4 x0 = acc[ai][bj][m][0], x1 = acc[ai][bj][m][1];
                    if (Xout) { *(f32x4*)(Xout + off + bj * HALF) = x0; *(f32x4*)(Xout + off + bj * HALF + 4) = x1; }
                    sq += ((x0[0] * x0[0] + x0[1] * x0[1]) + (x0[2] * x0[2] + x0[3] * x0[3])) + ((x1[0] * x1[0] + x1[1] * x1[1]) + (x1[2] * x1[2] + x1[3] * x1[3]));
                    u32x4 w; w.x = cvt_pk_bf16(x0[0], x0[1]); w.y = cvt_pk_bf16(x0[2], x0[3]); w.z = cvt_pk_bf16(x1[0], x1[1]); w.w = cvt_pk_bf16(x1[2], x1[3]);
                    *(u32x4*)(XB + off + bj * HALF) = w; }
                sq += __shfl_xor(sq, 16); sq += __shfl_xor(sq, 32);
                if (fq == 0) SS[(size_t)row * 16 + u.pn * 4 + wc] = sq; }
    }
};


template <class Epi, class Sched, bool ALIGN_EPI = false, bool SP2 = false>
__device__ __forceinline__ void gemm_phase(PG8_LAS unsigned char* lds, const Gemm g, const Sched& S, const Epi& E) {
    int tid_ = threadIdx.x; asm volatile("" : "+v"(tid_));
    const int tid = tid_, wid = __builtin_amdgcn_readfirstlane(tid >> 6), lane = tid & 63, wr = wid >> 2, wc = wid & 3, fr = lane & 15, fq = lane >> 4;
    const int K = g.K, nt = K / BK;
    unsigned voffA[2], voffB[2];
#pragma unroll
    for (int i = 0; i < 2; ++i) { int R, C; stage_rc(tid * 16 + i * 8192, R, C); const int Rb = Epi::PERM ? ((R & ~31) + perm32(R & 31)) : R;
        voffA[i] = (unsigned)(R * K + C) * 2u; voffB[i] = (unsigned)(Rb * K + C) * 2u; }
    const size_t kstep = (size_t)(BK * 2);
    const size_t hstep = (size_t)HALF * K * 2;
    const size_t tstep = 2 * hstep;
    const unsigned ldsw = (unsigned)wid * 1024u;
    const int aoff = lds_byte(wr * 64 + fr, fq * 8), boff = lds_byte(wc * 32 + fr, fq * 8);
#define PG8_SA(b, h) (((b) * 2 + (h)) * HTB)
#define PG8_SB(b, h) ((4 + (b) * 2 + (h)) * HTB)
#define PG8_STAGE(bufoff, gbase, voff) do { _Pragma("unroll") for (int _i = 0; _i < 2; ++_i) \
        __builtin_amdgcn_global_load_lds((const unsigned*)((const char*)(gbase) + (voff)[_i]), (PG8_LAS unsigned*)(lds + (bufoff) + ldsw + _i * 8192), 16, 0, 0); } while (0)
#define PG8_LDA(dst, b, h) do { _Pragma("unroll") for (int m = 0; m < 4; ++m) _Pragma("unroll") for (int k = 0; k < 2; ++k) dst[m][k] = *(const PG8_LAS bf16x8*)(lds + PG8_SA(b, h) + aoff + m * 2048 + k * 1024); } while (0)
#define PG8_LDB(dst, b, h) do { _Pragma("unroll") for (int n = 0; n < 2; ++n) _Pragma("unroll") for (int k = 0; k < 2; ++k) dst[n][k] = *(const PG8_LAS bf16x8*)(lds + PG8_SB(b, h) + boff + n * 2048 + k * 1024); } while (0)
#define PG8_MMA(ai, bj, At, Bt) do { __builtin_amdgcn_s_setprio(1); _Pragma("unroll") for (int m = 0; m < 4; ++m) _Pragma("unroll") for (int n = 0; n < 2; ++n) _Pragma("unroll") for (int k = 0; k < 2; ++k) \
        acc[ai][bj][m][n] = __builtin_amdgcn_mfma_f32_16x16x32_bf16(Bt[n][k], At[m][k], acc[ai][bj][m][n], 0, 0, 0); __builtin_amdgcn_s_setprio(0); } while (0)
#define PG8_WAIT_V(n) asm volatile("s_waitcnt vmcnt(" #n ")" ::: "memory")
#define PG8_WAIT_L(n) asm volatile("s_waitcnt lgkmcnt(" #n ")" ::: "memory")
#define PG8_BAR __builtin_amdgcn_s_barrier()
#define PG8_SCHED __builtin_amdgcn_sched_barrier(0)
    Unit cur, nxt; int ui = 0;
    if (!S.next(0, cur)) return;
    f32x4 acc[2][2][4][2];
    if constexpr (Epi::INIT_ACC) E.init(acc, cur, wr, wc, fr, fq);
    else {
#pragma unroll
    for (int a = 0; a < 2; ++a)
#pragma unroll
        for (int b = 0; b < 2; ++b)
#pragma unroll
            for (int m = 0; m < 4; ++m)
#pragma unroll
                for (int n = 0; n < 2; ++n) acc[a][b][m][n] = (f32x4){0.f, 0.f, 0.f, 0.f};
    }
    bf16x8 At[4][2], B0[2][2], B1[2][2];
    const char* cA = (const char*)g.A + (size_t)cur.pm * tstep; const char* cB = (const char*)g.Bt + (size_t)cur.pn * tstep;
    S.a_ready(cur);
    if constexpr (Epi::PREP) E.prep(cur, (PG8_LAS float*)(lds + STAGE_BYTES) + (ui & 1) * 256, tid);
    if constexpr (SP2) {
        PG8_STAGE(PG8_SB(0, 0), cB, voffB); PG8_STAGE(PG8_SB(0, 1), cB + hstep, voffB); PG8_STAGE(PG8_SA(0, 0), cA, voffA); PG8_STAGE(PG8_SA(0, 1), cA + hstep, voffA);
        if (wr == 1) PG8_BAR;
        PG8_WAIT_V(2); PG8_BAR;
        PG8_STAGE(PG8_SB(1, 0), cB + kstep, voffB); PG8_STAGE(PG8_SA(1, 0), cA + kstep, voffA); PG8_STAGE(PG8_SB(1, 1), cB + hstep + kstep, voffB);
        PG8_WAIT_V(6); PG8_BAR;
    } else {
        PG8_STAGE(PG8_SB(0, 0), cB, voffB); PG8_STAGE(PG8_SA(0, 0), cA, voffA); PG8_STAGE(PG8_SB(0, 1), cB + hstep, voffB); PG8_STAGE(PG8_SA(0, 1), cA + hstep, voffA);
        if (wr == 1) PG8_BAR;
        PG8_WAIT_V(4); PG8_BAR;
        PG8_STAGE(PG8_SB(1, 0), cB + kstep, voffB); PG8_STAGE(PG8_SA(1, 0), cA + kstep, voffA); PG8_STAGE(PG8_SB(1, 1), cB + hstep + kstep, voffB);
        PG8_WAIT_V(6); PG8_BAR;
    }
    for (;;) {
        const bool has_next = S.next(ui + 1, nxt);
        const char* nA = has_next ? (const char*)g.A + (size_t)nxt.pm * tstep : cA; const char* nB = has_next ? (const char*)g.Bt + (size_t)nxt.pn * tstep : cB;
        for (int t = 0; t < nt; t += 2) {
            const bool last = (t == nt - 2);
            const char* a1 = cA + (size_t)(t + 1) * kstep;
            const char* a2 = last ? nA : cA + (size_t)(t + 2) * kstep; const char* b2 = last ? nB : cB + (size_t)(t + 2) * kstep;
            const char* a3 = a2 + kstep; const char* b3 = b2 + kstep;
            if (last && has_next) S.a_ready(nxt);
            if constexpr (SP2) {
            PG8_LDB(B0, 0, 0); PG8_LDB(B1, 0, 1); PG8_SCHED; PG8_LDA(At, 0, 0); PG8_STAGE(PG8_SA(1, 1), a1 + hstep, voffA);
            PG8_WAIT_V(8); PG8_WAIT_L(0); PG8_BAR; PG8_MMA(0, 0, At, B0); PG8_MMA(0, 1, At, B1); PG8_BAR; PG8_SCHED;
            PG8_LDA(At, 0, 1); PG8_STAGE(PG8_SB(0, 0), b2, voffB); PG8_STAGE(PG8_SB(0, 1), b2 + hstep, voffB); PG8_STAGE(PG8_SA(0, 0), a2, voffA);
            PG8_WAIT_V(8); PG8_WAIT_L(0); PG8_BAR; PG8_MMA(1, 0, At, B0); PG8_MMA(1, 1, At, B1); PG8_BAR; PG8_SCHED;
            PG8_LDB(B0, 1, 0); PG8_LDB(B1, 1, 1); PG8_SCHED; PG8_LDA(At, 1, 0); PG8_STAGE(PG8_SA(0, 1), a2 + hstep, voffA);
            PG8_WAIT_V(8); PG8_WAIT_L(0); PG8_BAR; PG8_MMA(0, 0, At, B0); PG8_MMA(0, 1, At, B1); PG8_BAR; PG8_SCHED;
            PG8_LDA(At, 1, 1); PG8_STAGE(PG8_SB(1, 0), b3, voffB); PG8_STAGE(PG8_SB(1, 1), b3 + hstep, voffB); PG8_STAGE(PG8_SA(1, 0), a3, voffA);
            PG8_WAIT_V(8); PG8_WAIT_L(0); PG8_BAR; PG8_MMA(1, 0, At, B0); PG8_MMA(1, 1, At, B1); PG8_BAR; PG8_SCHED;
            } else {
            PG8_LDB(B0, 0, 0); PG8_SCHED; PG8_LDA(At, 0, 0); PG8_STAGE(PG8_SA(1, 1), a1 + hstep, voffA);
            PG8_WAIT_L(8); PG8_BAR; PG8_WAIT_L(0); PG8_MMA(0, 0, At, B0); PG8_BAR; PG8_SCHED;
            PG8_LDB(B1, 0, 1); PG8_STAGE(PG8_SB(0, 0), b2, voffB);
            PG8_BAR; PG8_WAIT_L(0); PG8_MMA(0, 1, At, B1); PG8_BAR;
            PG8_LDA(At, 0, 1); PG8_STAGE(PG8_SA(0, 0), a2, voffA);
            PG8_BAR; PG8_WAIT_L(0); PG8_MMA(1, 0, At, B0); PG8_BAR; PG8_SCHED;
            PG8_STAGE(PG8_SB(0, 1), b2 + hstep, voffB);
            PG8_WAIT_V(6); PG8_BAR; PG8_MMA(1, 1, At, B1); PG8_BAR;
            PG8_LDB(B0, 1, 0); PG8_SCHED; PG8_LDA(At, 1, 0); PG8_STAGE(PG8_SA(0, 1), a2 + hstep, voffA);
            PG8_WAIT_L(8); PG8_BAR; PG8_WAIT_L(0); PG8_MMA(0, 0, At, B0); PG8_BAR; PG8_SCHED;
            PG8_LDB(B1, 1, 1); PG8_STAGE(PG8_SB(1, 0), b3, voffB);
            PG8_BAR; PG8_WAIT_L(0); PG8_MMA(0, 1, At, B1); PG8_BAR;
            PG8_LDA(At, 1, 1); PG8_STAGE(PG8_SA(1, 0), a3, voffA);
            PG8_BAR; PG8_WAIT_L(0); PG8_MMA(1, 0, At, B0); PG8_BAR; PG8_SCHED;
            PG8_STAGE(PG8_SB(1, 1), b3 + hstep, voffB);
            PG8_WAIT_V(6); PG8_BAR; PG8_MMA(1, 1, At, B1); PG8_BAR;
            }
        }
        if constexpr (ALIGN_EPI) { if (wr == 0) PG8_BAR; }
        if constexpr (!Epi::AFTER_DRAIN) { if constexpr (Epi::PREP) E.epi(acc, cur, wr, wc, fr, fq, (const PG8_LAS float*)(lds + STAGE_BYTES) + (ui & 1) * 256); else E(acc, cur, wr, wc, fr, fq); S.done(cur); }
        if (!has_next) break;
        if constexpr (Epi::INIT_ACC) E.init(acc, nxt, wr, wc, fr, fq);
        else {
#pragma unroll
        for (int a = 0; a < 2; ++a)
#pragma unroll
            for (int b = 0; b < 2; ++b)
#pragma unroll
                for (int m = 0; m < 4; ++m)
#pragma unroll
                    for (int n = 0; n < 2; ++n) acc[a][b][m][n] = (f32x4){0.f, 0.f, 0.f, 0.f};
        }
        cur = nxt; cA = nA; cB = nB; ++ui;
        if constexpr (Epi::PREP) E.prep(cur, (PG8_LAS float*)(lds + STAGE_BYTES) + (ui & 1) * 256, tid);
        if constexpr (ALIGN_EPI) { if (wr == 1) PG8_BAR; }
    }
    PG8_WAIT_V(0);
    if constexpr (!ALIGN_EPI) { if (wr == 0) PG8_BAR; }
    PG8_BAR;
    if constexpr (Epi::AFTER_DRAIN) { E.fused(acc, cur, wr, wc, fr, fq, lds, wid, lane); S.done(cur); }
#undef PG8_SA
#undef PG8_SB
#undef PG8_STAGE
#undef PG8_LDA
#undef PG8_LDB
#undef PG8_MMA
#undef PG8_WAIT_V
#undef PG8_WAIT_L
#undef PG8_BAR
#undef PG8_SCHED
}
}
#define GAS __attribute__((address_space(1)))
#define LAS __attribute__((address_space(3)))
typedef unsigned short bf16;
typedef unsigned v4u __attribute__((ext_vector_type(4)));
typedef float f32x4 __attribute__((ext_vector_type(4)));
typedef short bf16x8 __attribute__((ext_vector_type(8)));
typedef GAS unsigned gu32;
typedef GAS unsigned long long gu64;
#define RLX_AGENT __ATOMIC_RELAXED, __HIP_MEMORY_SCOPE_AGENT
#define LDS_WAIT() asm volatile("s_waitcnt lgkmcnt(0)" ::: "memory")
#define VM_WAIT() asm volatile("s_waitcnt vmcnt(0)" ::: "memory")
__device__ __forceinline__ unsigned long long rt() { return __builtin_amdgcn_s_memrealtime(); }
__device__ __forceinline__ unsigned pk2(float lo, float hi) { typedef float f2_ __attribute__((ext_vector_type(2))); typedef __bf16 b2_ __attribute__((ext_vector_type(2))); f2_ v = {lo, hi}; b2_ b = __builtin_convertvector(v, b2_); return __builtin_bit_cast(unsigned, b); }
__device__ __forceinline__ unsigned f2bf(float f) { return pk2(f, 0.f) & 0xffffu; }
template <int CTRL> __device__ __forceinline__ float lane_dpp(float v) { return __builtin_bit_cast(float, __builtin_amdgcn_update_dpp(0, __builtin_bit_cast(int, v), CTRL, 0xf, 0xf, true)); }
template <int CTRL> __device__ __forceinline__ int lane_dpp_i(int v) { return __builtin_amdgcn_update_dpp(0, v, CTRL, 0xf, 0xf, true); }
constexpr int DPP_XOR1 = 0xB1, DPP_XOR2 = 0x4E, DPP_HALF_MIRROR = 0x141, DPP_MIRROR = 0x140;
__device__ __forceinline__ float lane_sum16(float v) { auto rr = __builtin_amdgcn_permlane16_swap(__builtin_bit_cast(unsigned, v), __builtin_bit_cast(unsigned, v), false, false); return __builtin_bit_cast(float, rr[0]) + __builtin_bit_cast(float, rr[1]); }
__device__ __forceinline__ float lane_sum32(float v) { auto rr = __builtin_amdgcn_permlane32_swap(__builtin_bit_cast(unsigned, v), __builtin_bit_cast(unsigned, v), false, false); return __builtin_bit_cast(float, rr[0]) + __builtin_bit_cast(float, rr[1]); }
#define XB_TMO      128
#define XB_XCNT(j)  (256  + 64 * (j))
#define XB_XSUB(j)  (1280 + 64 * (j))
#define XB_XGEN(j)  (2304 + 64 * (j))
#define XB_TOP      3328
#define XB_TOPGEN   3392
#define XCD_BAR_WORDS 3456
#define XB_SPIN_CAP (1u << 18)

__device__ __forceinline__ unsigned xb_ld(unsigned* p)              { return __hip_atomic_load(p, __ATOMIC_RELAXED, __HIP_MEMORY_SCOPE_AGENT); }
__device__ __forceinline__ unsigned xb_add(unsigned* p, unsigned v) { return __hip_atomic_fetch_add(p, v, __ATOMIC_RELAXED, __HIP_MEMORY_SCOPE_AGENT); }
__device__ __forceinline__ unsigned xb_xcc_id() { return (unsigned)__builtin_amdgcn_s_getreg((3 << 11) | 20) & 0xFu; }
#define XB_SPIN(cond, bar) do { unsigned _sp = 0; while (cond) { __builtin_amdgcn_s_sleep(1); \
    if ((++_sp & 255u) == 0u) { if (xb_ld(&(bar)[XB_TMO])) break; if (_sp > XB_SPIN_CAP) { atomicAdd(&(bar)[XB_TMO], 1u); break; } } } } while (0)

struct XcdBarrier {
    unsigned* bar; unsigned x;
    volatile LAS unsigned* st;
};

__device__ __forceinline__ XcdBarrier xcd_barrier_post(unsigned* bar, volatile LAS unsigned* st) {
    XcdBarrier b; b.bar = bar; b.x = xb_xcc_id(); b.st = st;
    if (threadIdx.x == 0) (void)xb_add(&bar[XB_XCNT(b.x)], 1u);
    return b;
}
__device__ __forceinline__ void xcd_barrier_complete(unsigned* bar, unsigned x, unsigned& nloc, unsigned& nx) {
    const unsigned G = gridDim.x * gridDim.y * gridDim.z;
    unsigned sum, cnt, mine, sp = 0u;
    for (;;) {
        sum = 0u; cnt = 0u; mine = 0u;
#pragma unroll
        for (unsigned j = 0; j < 16; ++j) { const unsigned c = xb_ld(&bar[XB_XCNT(j)]); sum += c; cnt += (c > 0u) ? 1u : 0u; mine = (j == x) ? c : mine; }
        if (sum == G) break;
        __builtin_amdgcn_s_sleep(1);
        if ((++sp & 255u) == 0u) { if (xb_ld(&bar[XB_TMO])) break; if (sp > XB_SPIN_CAP) { atomicAdd(&bar[XB_TMO], 1u); break; } }
    }
    nloc = mine > 0u ? mine : 1u; nx = cnt > 0u ? cnt : 1u;
}

__device__ __forceinline__ void xcd_barrier(const XcdBarrier& b) {
    asm volatile("s_waitcnt vmcnt(0)" ::: "memory");
    __syncthreads();
    if (threadIdx.x == 0) {
        unsigned* bar = b.bar;
        __builtin_amdgcn_s_waitcnt(0);
        unsigned nloc = b.st[0], nx = b.st[1];
        if (nloc == 0u) { xcd_barrier_complete(bar, b.x, nloc, nx); b.st[0] = nloc; b.st[1] = nx; }
        const unsigned old = xb_add(&bar[XB_XSUB(b.x)], 1u);
        const unsigned gen = old / nloc;
        if (old + 1u == (gen + 1u) * nloc) {
            __builtin_amdgcn_fence(__ATOMIC_RELEASE, "agent");
            asm volatile("s_waitcnt vmcnt(0)" ::: "memory");
            const unsigned og = xb_add(&bar[XB_TOP], 1u);
            const unsigned tg = og / nx;
            if (og + 1u == (tg + 1u) * nx) xb_add(&bar[XB_TOPGEN], 1u);
            else XB_SPIN(xb_ld(&bar[XB_TOPGEN]) == tg, bar);
            __builtin_amdgcn_fence(__ATOMIC_ACQUIRE, "agent");
            xb_add(&bar[XB_XGEN(b.x)], 1u);
            asm volatile("s_waitcnt vmcnt(0)" ::: "memory");
        } else {
            XB_SPIN(xb_ld(&bar[XB_XGEN(b.x)]) == gen, bar);
            __builtin_amdgcn_fence(__ATOMIC_ACQUIRE, "agent");
            asm volatile("s_waitcnt vmcnt(0)" ::: "memory");
        }
    }
    __syncthreads();
}
constexpr int NB_ = 8, T_ = 2048, D_ = 1024, M_ = NB_ * T_, DEPTH_ = 4, MEMLEN_ = 256, MM_ = NB_ * MEMLEN_, FF_ = 4096;
constexpr int NPROJ = 3072;
constexpr float LOG2E = 1.4426950408889634f, EPS_ = 1e-6f;
constexpr float C2_64 = 0.125f * LOG2E;
constexpr float C2_128 = 0.08838834764831845f * LOG2E;
constexpr int EC_FQ = 0, EC_FK = 512, EC_FV = 1024, EC_NQ = 1536, EC_KC = 2048, EC_VC = 2176, EC_KSL = 2304, EC_VSL = 2432, EC_KWN = 2560, EC_VWN = 2688, EC_FF = 2816, EC_NG = 2824, EC_END = 2848;
constexpr int OC_SQ = 0, OC_SK = 1024, OC_SV = 2048;

constexpr size_t MiB = 1u << 20;
constexpr size_t WS_CTL = 0, CTL_ZERO_BYTES = 64 * 1024;
constexpr size_t WS_SS = 1 * MiB;
constexpr size_t WS_LF = 2 * MiB;
constexpr size_t WS_GT = 3 * MiB;
constexpr size_t WS_KCB = 2 * MiB + 512 * 1024, WS_VCB = 2 * MiB + 768 * 1024;
constexpr size_t WS_CW1 = 4 * MiB + 512 * 1024;
constexpr size_t WS_CW2 = 5 * MiB + 512 * 1024, WS_CB1 = WS_CW2 + 64 * 1024;
constexpr size_t WS_KC = 5 * MiB + 768 * 1024, WS_VC = 6 * MiB + 384 * 1024;
constexpr size_t WS_MEMN = 7 * MiB;
constexpr size_t WS_MEMKV = 11 * MiB;
constexpr size_t WS_WIN = 16 * MiB, WS_WOUT = 40 * MiB, WS_WQ = 48 * MiB, WS_WKV = 52 * MiB, WS_WO = 60 * MiB, WS_W1 = 64 * MiB, WS_W2 = 96 * MiB;
constexpr size_t WS_XB = 128 * MiB;
constexpr size_t WS_ARENA = 160 * MiB;
constexpr size_t WS_PROJ = WS_ARENA, WS_AO = WS_ARENA + 96 * MiB, WS_QX = WS_ARENA, WS_AOX = WS_ARENA + 16 * MiB, WS_H = WS_ARENA;
constexpr size_t WS_END = 288 * MiB;
constexpr int CW_BAR = 4096;
constexpr int CW_CONV = 8192;
static_assert((CW_BAR + XCD_BAR_WORDS) * 4 <= (int)CTL_ZERO_BYTES, "ctl");
static_assert(WS_KC + 16 * 127 * 64 * 4 <= WS_VC && WS_VC + 16 * 127 * 64 * 4 <= WS_MEMN && WS_CB1 + 1024 <= WS_KC && WS_CW1 + 4 * 64 * 2048 * 2 <= WS_CW2 && WS_GT + (size_t)16384 * 24 * 4 <= WS_CW1 && WS_VCB + 16 * 128 * 64 * 2 <= WS_GT, "small-buffer map");

constexpr int RING_OFF = 0, RING_BYTES = 131072;
constexpr int LDS_BYTES = 147456;
constexpr int LDSCTL_OFF = LDS_BYTES - 512, MISC_OFF = LDSCTL_OFF + 320;
constexpr int NWAVES = 8, NTHR = 512;

__device__ const unsigned char T5_BUCKET[128] = {0, 1, 2, 3, 4, 5, 6, 7, 8, 9, 10, 11, 12, 13, 14, 15, 16, 16, 16, 17, 17, 18, 18, 18, 19, 19, 19, 20, 20, 20, 20, 21, 21, 21, 21, 22, 22, 22, 22, 22, 23, 23, 23, 23, 23, 23, 24, 24, 24, 24, 24, 24, 25, 25, 25, 25, 25, 25, 25, 26, 26, 26, 26, 26, 26, 26, 26, 27, 27, 27, 27, 27, 27, 27, 27, 27, 27, 28, 28, 28, 28, 28, 28, 28, 28, 28, 28, 29, 29, 29, 29, 29, 29, 29, 29, 29, 29, 29, 29, 30, 30, 30, 30, 30, 30, 30, 30, 30, 30, 30, 30, 30, 30, 31, 31, 31, 31, 31, 31, 31, 31, 31, 31, 31, 31, 31, 31, 31};

struct Args {
    const float *x, *mem, *rel_bias, *mem_norm_g, *norm_mix_g, *norm_xattn_g, *norm_mlp_g, *final_norm_g, *w_in_even, *b_forget, *cmp_pe_k, *cmp_w1_k, *cmp_w2_k, *cmp_pe_v, *cmp_w1_v, *cmp_w2_v,
        *w_out_even, *w_in_odd, *w_out_odd, *xa_wq, *xa_wkv, *xa_wo, *mlp_w1, *mlp_w2;
    float* out; unsigned char* ws; int ph_lo, ph_hi;
};
struct Frame {
    LAS unsigned char* lds; int tid, lane, wave, G, vcu;
    unsigned char* ws;
};
__device__ __forceinline__ const float* karg(int i) {
    auto ks = (const float* const __attribute__((address_space(4)))*)__builtin_amdgcn_kernarg_segment_ptr();
    asm volatile("" : "+s"(ks));
    return ks[i];
}
__device__ __forceinline__ float bf2f(unsigned short v) { return __uint_as_float((unsigned)v << 16); }
__device__ __forceinline__ float wave_sum(float v) {
#pragma unroll
    for (int o = 1; o < 64; o <<= 1) v += __shfl_xor(v, o);
    return v;
}
__device__ __forceinline__ void ld8(const bf16* p, float* o) {
    const v4u w = *(const v4u*)p;
    o[0] = __uint_as_float(w.x << 16); o[1] = __uint_as_float(w.x & 0xffff0000u); o[2] = __uint_as_float(w.y << 16); o[3] = __uint_as_float(w.y & 0xffff0000u);
    o[4] = __uint_as_float(w.z << 16); o[5] = __uint_as_float(w.z & 0xffff0000u); o[6] = __uint_as_float(w.w << 16); o[7] = __uint_as_float(w.w & 0xffff0000u);
}

struct WMeta { const float* gain; float cs; bf16* dst; int K, k0, n0; };
__device__ __forceinline__ void witem_load(const Frame& F, int layer, int kind, int item, f32x4 (&v)[16], WMeta& wm) {
    const int lane = F.lane; const bool even = (layer & 1) == 0; const int e2 = layer >> 1;
    const float* W; const float* gain = nullptr; int K, Nsrc, Ndst; bf16* dst;
    switch (kind) {
        case 0: K = 1024; Ndst = NPROJ; gain = karg(4) + layer * 1024; dst = (bf16*)(F.ws + WS_WIN) + (size_t)layer * NPROJ * 1024;
                if (even) { W = karg(8) + (size_t)e2 * 1024 * 2848; Nsrc = 2848; } else { W = karg(17) + (size_t)e2 * 1024 * 3072; Nsrc = 3072; } break;
        case 1: K = 1024; Ndst = 1024; Nsrc = 1024; W = (even ? karg(16) : karg(18)) + (size_t)e2 * 1024 * 1024; dst = (bf16*)(F.ws + WS_WOUT) + (size_t)layer * 1024 * 1024; break;
        case 2: K = 1024; Ndst = 512; Nsrc = 512; W = karg(19) + (size_t)layer * 1024 * 512; gain = karg(5) + layer * 1024; dst = (bf16*)(F.ws + WS_WQ) + (size_t)layer * 512 * 1024; break;
        case 3: K = 1024; Ndst = 1024; Nsrc = 1024; W = karg(20) + (size_t)layer * 1024 * 1024; dst = (bf16*)(F.ws + WS_WKV) + (size_t)layer * 1024 * 1024; break;
        case 4: K = 512; Ndst = 1024; Nsrc = 1024; W = karg(21) + (size_t)layer * 512 * 1024; dst = (bf16*)(F.ws + WS_WO) + (size_t)layer * 1024 * 512; break;
        case 5: K = 1024; Ndst = 4096; Nsrc = 4096; W = karg(22) + (size_t)layer * 1024 * 4096; gain = karg(6) + layer * 1024; dst = (bf16*)(F.ws + WS_W1) + (size_t)layer * 4096 * 1024; break;
        case 6: K = 4096; Ndst = 1024; Nsrc = 1024; W = karg(23) + (size_t)layer * 4096 * 1024; dst = (bf16*)(F.ws + WS_W2) + (size_t)layer * 1024 * 4096; break;
        case 7: K = 2048; Ndst = 64; Nsrc = 64; W = ((layer & 1) ? karg(14) : karg(11)) + (size_t)(layer >> 1) * 131072; dst = (bf16*)(F.ws + WS_CW1) + (size_t)layer * 64 * 2048; break;
        default: K = 64; Ndst = 64; Nsrc = 64; W = ((layer & 1) ? karg(15) : karg(12)) + (size_t)(layer >> 1) * 4096; dst = (bf16*)(F.ws + WS_CW2) + (size_t)layer * 64 * 64; break;
    }
    const int nblk = Ndst / 64, kb = item / nblk, nb = item % nblk, k0 = 64 * kb, n0 = 64 * nb;
    const int nd = n0 + 4 * (lane & 15); int sc = nd; float cs = 1.f;
    if (kind == 0) {
        if (even) {
            if (nd < EC_NQ) sc = nd;
            else if (nd < EC_FF) sc = nd + 8;
            else if (nd < EC_NG) sc = 1536 + (nd - EC_FF);
            else if (nd < EC_END) sc = nd;
            else sc = -1;
            if (nd < 512 || (nd >= EC_NQ && nd < EC_KC)) cs = C2_64;
        } else { if (nd < 1024) cs = C2_64; }
    } else if (kind == 2) cs = C2_128;
#pragma unroll
    for (int i = 0; i < 16; ++i) { const int kk = 4 * i + (lane >> 4); v[i] = (sc >= 0) ? __builtin_nontemporal_load((const f32x4*)(W + (size_t)(k0 + kk) * Nsrc + sc)) : (f32x4){0.f, 0.f, 0.f, 0.f}; }
    wm.gain = gain; wm.cs = cs; wm.dst = dst; wm.K = K; wm.k0 = k0; wm.n0 = n0;
}
__device__ __forceinline__ void witem_finish(const Frame& F, const f32x4 (&v)[16], const WMeta& wm, LAS float* scr) {
    const int lane = F.lane; const float* gain = wm.gain; const float cs = wm.cs; bf16* dst = wm.dst; const int K = wm.K, k0 = wm.k0, n0 = wm.n0;
#pragma unroll
    for (int i = 0; i < 16; ++i) { const int kk = 4 * i + (lane >> 4); const float sg = gain ? cs * gain[k0 + kk] : cs; *(LAS f32x4*)(scr + kk * 68 + ((4 * (lane & 15)) ^ (4 * ((kk >> 3) & 7)))) = v[i] * sg; }
    LDS_WAIT(); asm volatile("" ::: "memory");
    const int c = lane & 7;
#pragma unroll
    for (int i = 0; i < 8; ++i) { const int r = 8 * i + (lane >> 3); const LAS float* s = scr + (8 * c) * 68 + (r ^ (4 * c));
        v4u o; o.x = pk2(s[0 * 68], s[1 * 68]); o.y = pk2(s[2 * 68], s[3 * 68]); o.z = pk2(s[4 * 68], s[5 * 68]); o.w = pk2(s[6 * 68], s[7 * 68]);
        *(GAS v4u*)(dst + (size_t)(n0 + r) * K + k0 + 8 * c) = o; }
    LDS_WAIT(); asm volatile("" ::: "memory");
}
__device__ __forceinline__ void p0_weight_item(const Frame& F, const Args&, int layer, int kind, int item, LAS float* scr) { f32x4 v[16]; WMeta wm; witem_load(F, layer, kind, item, v, wm); witem_finish(F, v, wm, scr); }
__device__ __forceinline__ void convert_layer_weights(const Frame& F, const Args& A, int layer, int gw, int NGW) {
    LAS float* scr = (LAS float*)(F.lds + RING_OFF + F.wave * 17408);
    constexpr int I0 = 16 * 48, I1 = 16 * 16, I2 = 16 * 8, I3 = 16 * 16, I4 = 8 * 16, I5 = 16 * 64, I6 = 64 * 16, IL = I0 + I1 + I2 + I3 + I4 + I5 + I6;
    auto load = [&](int it, f32x4 (&v)[16], WMeta& wm) __attribute__((always_inline)) {
        int r = it; int kind = 0;
        if (r >= I0) { r -= I0; kind = 1; if (r >= I1) { r -= I1; kind = 2; if (r >= I2) { r -= I2; kind = 3; if (r >= I3) { r -= I3; kind = 4; if (r >= I4) { r -= I4; kind = 5; if (r >= I5) { r -= I5; kind = 6; } } } } } }
        witem_load(F, layer, kind, r, v, wm); };
    f32x4 va[16], vb[16]; WMeta ma, mb; int ita = gw;
    if (ita < IL) load(ita, va, ma);
    while (ita < IL) {
        const int itb = ita + NGW; if (itb < IL) load(itb, vb, mb);
        witem_finish(F, va, ma, scr);
        if (itb >= IL) break;
        ita = itb + NGW; if (ita < IL) load(ita, va, ma);
        witem_finish(F, vb, mb, scr);
    }
}
__device__ __forceinline__ void convert_layer_weights_queue(const Frame& F, const Args& A, int layer, gu32* ctr, LAS unsigned* lw) {
    LAS float* scr = (LAS float*)(F.lds + RING_OFF + F.wave * 17408);
    constexpr int I0 = 16 * 48, I1 = 16 * 16, I2 = 16 * 8, I3 = 16 * 16, I4 = 8 * 16, I5 = 16 * 64, I6 = 64 * 16, IL = I0 + I1 + I2 + I3 + I4 + I5 + I6;
    for (;;) {
        __syncthreads();
        if (F.tid == 0) *lw = __hip_atomic_fetch_add(ctr, 8u, __ATOMIC_RELAXED, __HIP_MEMORY_SCOPE_AGENT);
        __syncthreads();
        const int base = (int)*lw; if (base >= IL) break;
        const int it = base + F.wave;
        if (it < IL) { int r = it; int kind = 0;
            if (r >= I0) { r -= I0; kind = 1; if (r >= I1) { r -= I1; kind = 2; if (r >= I2) { r -= I2; kind = 3; if (r >= I3) { r -= I3; kind = 4; if (r >= I4) { r -= I4; kind = 5; if (r >= I5) { r -= I5; kind = 6; } } } } } }
            p0_weight_item(F, A, layer, kind, r, scr); }
    }
}
__device__ __forceinline__ void p0_prologue(const Frame& F, const Args& A) {
    LAS float* scr = (LAS float*)(F.lds + RING_OFF + F.wave * 17408);
    const int gw = F.vcu * NWAVES + F.wave, NGW = F.G * NWAVES;
    convert_layer_weights(F, A, 0, gw, NGW);
    for (int it = gw; it < 4 * 33; it += NGW) { const int mi = it / 33, r = it % 33; if (r < 32) p0_weight_item(F, A, mi, 7, r, scr); else p0_weight_item(F, A, mi, 8, 0, scr); }
    for (int it = gw; it < 256; it += NGW) { const int mi = it >> 6, e = it & 63; const float* pe = ((mi & 1) ? A.cmp_pe_v : A.cmp_pe_k) + (size_t)(mi >> 1) * 2048; const float* w1 = ((mi & 1) ? A.cmp_w1_v : A.cmp_w1_k) + (size_t)(mi >> 1) * 131072;
        float s = 0.f; for (int k = F.lane; k < 2048; k += 64) s += pe[k] * w1[(size_t)k * 64 + e];
        s = wave_sum(s); if (F.lane == 0) ((float*)(F.ws + WS_CB1))[it] = s; }
    for (int m = gw; m < MM_; m += NGW) {
        const GAS f32x4* xr = (const GAS f32x4*)(A.mem + (size_t)m * D_) + F.lane; const GAS f32x4* gr = (const GAS f32x4*)A.mem_norm_g + F.lane;
        f32x4 v[4]; float s = 0.f;
#pragma unroll
        for (int j = 0; j < 4; ++j) { v[j] = xr[64 * j]; s += (v[j].x * v[j].x + v[j].y * v[j].y) + (v[j].z * v[j].z + v[j].w * v[j].w); }
        const float r = 1.0f / sqrtf(wave_sum(s) * (1.f / D_) + EPS_);
        GAS unsigned long long* o8 = (GAS unsigned long long*)((bf16*)(F.ws + WS_MEMN) + (size_t)m * D_) + F.lane;
#pragma unroll
        for (int j = 0; j < 4; ++j) { const f32x4 g = gr[64 * j]; o8[64 * j] = (unsigned long long)pk2(v[j].x * r * g.x, v[j].y * r * g.y) | ((unsigned long long)pk2(v[j].z * r * g.z, v[j].w * r * g.w) << 32); }
    }
    for (int m0 = gw; m0 < M_; m0 += 4 * NGW) {
        f32x4 v[4][4];
#pragma unroll
        for (int q = 0; q < 4; ++q) { const int m = m0 + q * NGW; const GAS f32x4* xr = (const GAS f32x4*)(A.x + (size_t)(m < M_ ? m : M_ - 1) * D_) + F.lane;
#pragma unroll
            for (int j = 0; j < 4; ++j) v[q][j] = __builtin_nontemporal_load((const f32x4*)(xr + 64 * j)); }
#pragma unroll
        for (int q = 0; q < 4; ++q) { const int m = m0 + q * NGW; if (m >= M_) break; float s = 0.f;
#pragma unroll
            for (int j = 0; j < 4; ++j) s += (v[q][j].x * v[q][j].x + v[q][j].y * v[q][j].y) + (v[q][j].z * v[q][j].z + v[q][j].w * v[q][j].w);
            s = wave_sum(s);
            GAS unsigned long long* o8 = (GAS unsigned long long*)((bf16*)(F.ws + WS_XB) + (size_t)m * D_) + F.lane;
#pragma unroll
            for (int j = 0; j < 4; ++j) o8[64 * j] = (unsigned long long)pk2(v[q][j].x, v[q][j].y) | ((unsigned long long)pk2(v[q][j].z, v[q][j].w) << 32);
            if (F.lane < 16) ((GAS float*)(F.ws + WS_SS))[(size_t)m * 16 + F.lane] = (F.lane == 0) ? s : 0.f; }
    }
}
__device__ __forceinline__ void final_norm(const Frame& F, const Args& A) {
    const int gw = F.vcu * NWAVES + F.wave, NGW = F.G * NWAVES;
    for (int m = gw; m < M_; m += NGW) {
        GAS f32x4* xr = (GAS f32x4*)(A.out + (size_t)m * D_) + F.lane; const GAS f32x4* gr = (const GAS f32x4*)A.final_norm_g + F.lane;
        f32x4 v[4]; float s = 0.f;
#pragma unroll
        for (int j = 0; j < 4; ++j) { v[j] = xr[64 * j]; s += (v[j].x * v[j].x + v[j].y * v[j].y) + (v[j].z * v[j].z + v[j].w * v[j].w); }
        const float r = 1.0f / sqrtf(wave_sum(s) * (1.f / D_) + EPS_);
#pragma unroll
        for (int j = 0; j < 4; ++j) { const f32x4 g = gr[64 * j]; xr[64 * j] = (f32x4){v[j].x * r * g.x, v[j].y * r * g.y, v[j].z * r * g.z, v[j].w * r * g.w}; }
    }
}
constexpr float NEGBIG = -3.0e38f;
__device__ __forceinline__ void stage_kv64(LAS float* Ks, LAS float* Vs, const bf16* kbase, const bf16* vbase, int pitch, int tid) {
    const int key = tid >> 3, d0 = (tid & 7) * 8; float kf[8], vf[8];
    ld8(kbase + (size_t)key * pitch + d0, kf); ld8(vbase + (size_t)key * pitch + d0, vf);
#pragma unroll
    for (int i = 0; i < 8; ++i) { Ks[key * 64 + d0 + i] = kf[i]; Vs[key * 64 + d0 + i] = vf[i]; }
}
__device__ __forceinline__ float dot64(const float (&q)[64], const LAS float* k) {
    float a0 = 0.f, a1 = 0.f, a2 = 0.f, a3 = 0.f;
#pragma unroll
    for (int d = 0; d < 64; d += 4) { const f32x4 kv = *(const LAS f32x4*)(k + d); a0 += q[d] * kv[0]; a1 += q[d + 1] * kv[1]; a2 += q[d + 2] * kv[2]; a3 += q[d + 3] * kv[3]; }
    return (a0 + a1) + (a2 + a3);
}
__device__ __forceinline__ float dot64p(const unsigned (&qp)[32], const LAS float* k) {
    float a0 = 0.f, a1 = 0.f, a2 = 0.f, a3 = 0.f;
#pragma unroll
    for (int d = 0; d < 64; d += 4) { const f32x4 kv = *(const LAS f32x4*)(k + d); const unsigned w0 = qp[d >> 1], w1 = qp[(d >> 1) + 1];
        a0 += __uint_as_float(w0 << 16) * kv[0]; a1 += __uint_as_float(w0 & 0xffff0000u) * kv[1]; a2 += __uint_as_float(w1 << 16) * kv[2]; a3 += __uint_as_float(w1 & 0xffff0000u) * kv[3]; }
    return (a0 + a1) + (a2 + a3);
}
__device__ __forceinline__ void load_q64p(const bf16* p, unsigned (&qp)[32]) {
#pragma unroll
    for (int i = 0; i < 8; ++i) { const v4u w = *(const v4u*)(p + 8 * i); qp[4 * i] = w.x; qp[4 * i + 1] = w.y; qp[4 * i + 2] = w.z; qp[4 * i + 3] = w.w; }
}
__device__ __forceinline__ void osm4(float& m, float& l, float (&o)[64], const float (&x)[4], const bool (&ok)[4], const LAS float* v) {
    float mn = m;
#pragma unroll
    for (int i = 0; i < 4; ++i) mn = fmaxf(mn, ok[i] ? x[i] : NEGBIG);
    const float sc = exp2f(m - mn); float p[4];
#pragma unroll
    for (int i = 0; i < 4; ++i) p[i] = ok[i] ? exp2f(x[i] - mn) : 0.f;
    l = l * sc + ((p[0] + p[1]) + (p[2] + p[3])); m = mn;
#pragma unroll
    for (int d = 0; d < 64; d += 4) { const f32x4 v0 = *(const LAS f32x4*)(v + d), v1 = *(const LAS f32x4*)(v + 64 + d), v2 = *(const LAS f32x4*)(v + 128 + d), v3 = *(const LAS f32x4*)(v + 192 + d);
#pragma unroll
        for (int i = 0; i < 4; ++i) o[d + i] = o[d + i] * sc + (p[0] * v0[i] + p[1] * v1[i]) + (p[2] * v2[i] + p[3] * v3[i]); }
}
__device__ __forceinline__ void load_q64(const bf16* p, float (&q)[64]) {
#pragma unroll
    for (int i = 0; i < 8; ++i) { float t8[8]; ld8(p + 8 * i, t8);
#pragma unroll
        for (int j = 0; j < 8; ++j) q[8 * i + j] = t8[j]; }
}
__device__ __forceinline__ void store_o64(bf16* p, const float (&o)[64], float s) {
#pragma unroll
    for (int i = 0; i < 8; ++i) { v4u w; w.x = pk2(o[8 * i] * s, o[8 * i + 1] * s); w.y = pk2(o[8 * i + 2] * s, o[8 * i + 3] * s); w.z = pk2(o[8 * i + 4] * s, o[8 * i + 5] * s); w.w = pk2(o[8 * i + 6] * s, o[8 * i + 7] * s);
        *(v4u*)(p + 8 * i) = w; }
}

__device__ __forceinline__ void fox_naive_unit(unsigned char* ws, LAS unsigned char* lds, int u, int tid) {
    const int b = u >> 5, h = (u >> 2) & 7, qb = u & 3, t = qb * 512 + tid; const size_t row = (size_t)b * T_ + t;
    LAS float* Fs = (LAS float*)lds; LAS float* Ks = Fs + 2048; LAS float* Vs = Ks + 4096; LAS float* tot = Vs + 4096;
    const bf16* PROJ = (const bf16*)(ws + WS_PROJ); bf16* AO = (bf16*)(ws + WS_AO);
    const float* lf = (const float*)(ws + WS_LF) + (size_t)(b * 8 + h) * 2048;
    __syncthreads();
    { const f32x4 v = *(const f32x4*)(lf + 4 * tid); const float p0 = v[0], p1 = p0 + v[1], p2 = p1 + v[2], p3 = p2 + v[3];
      tot[tid] = p3; __syncthreads(); int cur = 0;
      for (int off = 1; off < 512; off <<= 1) { float x = tot[cur * 512 + tid]; if (tid >= off) x += tot[cur * 512 + tid - off]; tot[(cur ^ 1) * 512 + tid] = x; cur ^= 1; __syncthreads(); }
      const float ex = tot[cur * 512 + tid] - p3; Fs[4 * tid] = ex + p0; Fs[4 * tid + 1] = ex + p1; Fs[4 * tid + 2] = ex + p2; Fs[4 * tid + 3] = ex + p3; }
    __syncthreads();
    const float Ft = Fs[t];
    float q[64], o[64]; load_q64(PROJ + row * NPROJ + EC_FQ + h * 64, q);
#pragma unroll
    for (int d = 0; d < 64; ++d) o[d] = 0.f;
    float m = NEGBIG, l = 0.f; const int ntile = qb * 8 + 8;
    for (int kt = 0; kt < ntile; ++kt) {
        __syncthreads();
        stage_kv64(Ks, Vs, PROJ + ((size_t)b * T_ + kt * 64) * NPROJ + EC_FK + h * 64, PROJ + ((size_t)b * T_ + kt * 64) * NPROJ + EC_FV + h * 64, NPROJ, tid);
        __syncthreads();
        if (kt * 64 <= t) {
            for (int j0 = 0; j0 < 64; j0 += 4) { float x[4]; bool ok[4];
#pragma unroll
                for (int i = 0; i < 4; ++i) { const int s = kt * 64 + j0 + i; ok[i] = s <= t; x[i] = dot64(q, Ks + (j0 + i) * 64) + (Ft - Fs[s]); }
                osm4(m, l, o, x, ok, Vs + j0 * 64); }
        }
    }
    store_o64(AO + row * 1024 + h * 64, o, 1.0f / l);
}
__device__ __forceinline__ void sb_naive_unit(unsigned char* ws, LAS unsigned char* lds, int u, int tid) {
    const int b = u >> 6, h = (u >> 2) & 15, qb = u & 3, t = qb * 512 + tid; const size_t row = (size_t)b * T_ + t;
    LAS float* Ks = (LAS float*)lds; LAS float* Vs = Ks + 4096;
    const bf16* PROJ = (const bf16*)(ws + WS_PROJ); bf16* AO = (bf16*)(ws + WS_AO);
    float q[64], o[64]; load_q64(PROJ + row * NPROJ + OC_SQ + h * 64, q);
#pragma unroll
    for (int d = 0; d < 64; ++d) o[d] = 0.f;
    float acc = 0.f;
    for (int kt = qb * 8 + 7; kt >= 0; --kt) {
        __syncthreads();
        stage_kv64(Ks, Vs, PROJ + ((size_t)b * T_ + kt * 64) * NPROJ + OC_SK + h * 64, PROJ + ((size_t)b * T_ + kt * 64) * NPROJ + OC_SV + h * 64, NPROJ, tid);
        __syncthreads();
        if (kt * 64 < t) {
            for (int j0 = 60; j0 >= 0; j0 -= 4) { float a[4];
#pragma unroll
                for (int i = 3; i >= 0; --i) { const int s = kt * 64 + j0 + i; const bool ok = s < t; const float y = dot64(q, Ks + (j0 + i) * 64);
                    const float L = fmaxf(y, 0.f) + log2f(1.0f + exp2f(-fabsf(y)));
                    a[i] = ok ? exp2f(y - L + acc) : 0.f; acc -= ok ? L : 0.f; }
                const LAS float* v = Vs + j0 * 64;
#pragma unroll
                for (int d = 0; d < 64; d += 4) { const f32x4 v0 = *(const LAS f32x4*)(v + d), v1 = *(const LAS f32x4*)(v + 64 + d), v2 = *(const LAS f32x4*)(v + 128 + d), v3 = *(const LAS f32x4*)(v + 192 + d);
#pragma unroll
                    for (int i = 0; i < 4; ++i) o[d + i] += (a[0] * v0[i] + a[1] * v1[i]) + (a[2] * v2[i] + a[3] * v3[i]); }
            }
        }
        if (__syncthreads_and(acc < -200.f)) break;
    }
    store_o64(AO + row * 1024 + h * 64, o, 1.0f);
}
__device__ __forceinline__ void compress_naive_unit(const Args& a, unsigned char* ws, LAS unsigned char* lds, int u, int layer, int tid) {
    const int cch = u & 7; u >>= 3;
    const int b = u >> 2, g = (u >> 1) & 1, kv = u & 1, e2 = layer >> 1, lane = tid & 63, wave = tid >> 6;
    const bf16* PROJ = (const bf16*)(ws + WS_PROJ) + (size_t)b * T_ * NPROJ + (kv ? EC_VC : EC_KC) + g * 64;
    const float* pe = (kv ? a.cmp_pe_v : a.cmp_pe_k) + (size_t)e2 * 2048; const float* w1 = (kv ? a.cmp_w1_v : a.cmp_w1_k) + (size_t)e2 * 131072; const float* w2 = (kv ? a.cmp_w2_v : a.cmp_w2_k) + (size_t)e2 * 4096;
    float* out = (float*)(ws + (kv ? WS_VC : WS_KC)) + (size_t)(b * 2 + g) * 127 * 64;
    LAS float* xs = (LAS float*)lds + wave * 2176;
    LAS float* hs = xs + 2048;
    __syncthreads();
    for (int c = cch * 16 + wave; c < 127 && c < cch * 16 + 16; c += 8) {
        for (int i = lane; i < 2048; i += 64) { const int l = i >> 6, d = i & 63; xs[i] = bf2f(PROJ[(size_t)(16 * c + l) * NPROJ + d]) + pe[i]; }
        LDS_WAIT(); asm volatile("" ::: "memory");
        float acc = 0.f;
        for (int i = 0; i < 2048; i += 4) { const f32x4 xv = *(const LAS f32x4*)(xs + i);
            acc += xv[0] * w1[(size_t)i * 64 + lane]; acc += xv[1] * w1[(size_t)(i + 1) * 64 + lane]; acc += xv[2] * w1[(size_t)(i + 2) * 64 + lane]; acc += xv[3] * w1[(size_t)(i + 3) * 64 + lane]; }
        const float hg = 0.5f * acc * (1.0f + tanhf(0.7978845608028654f * (acc + 0.044715f * acc * acc * acc)));
        hs[lane] = hg; LDS_WAIT(); asm volatile("" ::: "memory");
        float o = 0.f;
        for (int e = 0; e < 64; ++e) o += hs[e] * w2[e * 64 + lane];
        out[(size_t)c * 64 + lane] = o;
        LDS_WAIT(); asm volatile("" ::: "memory");
    }
}
__device__ __forceinline__ void nsa_naive_unit(const Args& a, unsigned char* ws, LAS unsigned char* lds, int u, int tid) {
    const int b = u >> 5, g = (u >> 4) & 1, tb = u & 15, tl = tid & 127, r = tid >> 7, t = tb * 128 + tl, h = g * 4 + r; const size_t row = (size_t)b * T_ + t;
    LAS float* Ks = (LAS float*)lds; LAS float* Vs = Ks + 4096; LAS float* biasd = Vs + 4096  ; LAS float* slab = biasd + 528  ; LAS unsigned* selm = (LAS unsigned*)(slab + 16384)  ;
    const bf16* PROJ = (const bf16*)(ws + WS_PROJ); bf16* AO = (bf16*)(ws + WS_AO);
    __syncthreads();
    for (int i = tid; i < 4 * 129; i += NTHR) { const int rr = i / 129, dd = i % 129; const int bk = dd < 128 ? (int)T5_BUCKET[dd] : 31; biasd[rr * 132 + dd] = a.rel_bias[bk * 8 + g * 4 + rr] * LOG2E; }
    unsigned q[32]; float o[64]; load_q64p(PROJ + row * NPROJ + EC_NQ + h * 64, q);
    float* OF = (float*)(ws + WS_XB) + row * 512 + h * 64;
    const float* gt = (const float*)(ws + WS_GT) + row * 24 + h * 3; const float g0 = gt[0], g1 = gt[1], g2 = gt[2];
    const LAS float* bd = biasd + r * 132;
    const int nvalid = t >= 31 ? ((t - 31) >> 4) + 1 : 0;
    const float* KC = (const float*)(ws + WS_KC) + (size_t)(b * 2 + g) * 127 * 64; const float* VC = (const float*)(ws + WS_VC) + (size_t)(b * 2 + g) * 127 * 64;
    float m = NEGBIG, l = 0.f;
#pragma unroll
    for (int d = 0; d < 64; ++d) o[d] = 0.f;
    for (int ct = 0; ct < 2; ++ct) {
        __syncthreads();
        { const int key = tid >> 3, d0 = (tid & 7) * 8, c = ct * 64 + key;
#pragma unroll
          for (int i = 0; i < 8; ++i) { Ks[key * 64 + d0 + i] = c < 127 ? KC[(size_t)c * 64 + d0 + i] : 0.f; Vs[key * 64 + d0 + i] = c < 127 ? VC[(size_t)c * 64 + d0 + i] : 0.f; } }
        __syncthreads();
        if (ct * 64 < nvalid) {
            for (int j0 = 0; j0 < 64; j0 += 4) { float x[4]; bool ok[4];
#pragma unroll
                for (int i = 0; i < 4; ++i) { const int c = ct * 64 + j0 + i; ok[i] = c < nvalid; const int dist = ok[i] ? t - (16 * c + 31) : 0; x[i] = dot64p(q, Ks + (j0 + i) * 64) + bd[dist < 128 ? dist : 128]; }
                osm4(m, l, o, x, ok, Vs + j0 * 64); }
        }
    }
    const float il = nvalid > 0 ? 1.0f / l : 0.f;
#pragma unroll
    for (int d = 0; d < 64; d += 4) *(f32x4*)(OF + d) = (f32x4){g0 * il * o[d], g0 * il * o[d + 1], g0 * il * o[d + 2], g0 * il * o[d + 3]};
    { float prev = 0.f;
      for (int ct = 0; ct < 2; ++ct) {
        __syncthreads();
        { const int key = tid >> 3, d0 = (tid & 7) * 8, c = ct * 64 + key;
#pragma unroll
          for (int i = 0; i < 8; ++i) Ks[key * 64 + d0 + i] = c < 127 ? KC[(size_t)c * 64 + d0 + i] : 0.f; }
        __syncthreads();
        for (int nn = 0; nn < 16; ++nn) { float p[4];
#pragma unroll
            for (int i = 0; i < 4; ++i) { const int c = ct * 64 + nn * 4 + i; const bool ok = c < nvalid; const int dist = ok ? t - (16 * c + 31) : 0;
                const float x = dot64p(q, Ks + (nn * 4 + i) * 64) + bd[dist < 128 ? dist : 128]; p[i] = ok ? exp2f(x - m) * il : 0.f; }
            slab[(r * 128 + tl) * 32 + ct * 16 + nn] = prev + ((p[0] + p[1]) + (p[2] + p[3])); prev = p[3]; }
      } }
    __syncthreads();
    const int cur = t >> 6;
    if (tid < 128) {
        float s[32];
#pragma unroll
        for (int n = 0; n < 32; ++n) { const float v = (slab[(0 * 128 + tl) * 32 + n] + slab[(1 * 128 + tl) * 32 + n]) + (slab[(2 * 128 + tl) * 32 + n] + slab[(3 * 128 + tl) * 32 + n]);
            s[n] = (n > cur) ? -1.0f : ((n == 0 || n == cur || n == cur - 1) ? 1.0e4f : v); }
        unsigned mask = 0u;
        for (int k = 0; k < 8; ++k) { float best = -3.0e38f; int bi = 0;
#pragma unroll
            for (int n = 0; n < 32; ++n) if (s[n] > best) { best = s[n]; bi = n; }
#pragma unroll
            for (int n = 0; n < 32; ++n) s[n] = (n == bi) ? -3.0e38f : s[n];
            mask |= 1u << bi; }
        selm[tl] = mask;
    }
    __syncthreads();
    const unsigned mask = selm[tl];
    m = NEGBIG; l = 0.f;
#pragma unroll
    for (int d = 0; d < 64; ++d) o[d] = 0.f;
    for (int n = 0; n < 2 * tb + 2; ++n) {
        __syncthreads();
        stage_kv64(Ks, Vs, PROJ + ((size_t)b * T_ + n * 64) * NPROJ + EC_KSL + g * 64, PROJ + ((size_t)b * T_ + n * 64) * NPROJ + EC_VSL + g * 64, NPROJ, tid);
        __syncthreads();
        if (((mask >> n) & 1u) && n <= cur) {
            for (int j0 = 0; j0 < 64; j0 += 4) { float x[4]; bool ok[4];
#pragma unroll
                for (int i = 0; i < 4; ++i) { const int s = n * 64 + j0 + i; ok[i] = s <= t; const int dist = ok[i] ? t - s : 0; x[i] = dot64p(q, Ks + (j0 + i) * 64) + bd[dist < 128 ? dist : 128]; }
                osm4(m, l, o, x, ok, Vs + j0 * 64); }
        }
    }
    { const float s1 = g1 / l;
#pragma unroll
      for (int d = 0; d < 64; d += 4) { f32x4 v = *(const f32x4*)(OF + d); v[0] += s1 * o[d]; v[1] += s1 * o[d + 1]; v[2] += s1 * o[d + 2]; v[3] += s1 * o[d + 3]; *(f32x4*)(OF + d) = v; } }
    m = NEGBIG; l = 0.f;
#pragma unroll
    for (int d = 0; d < 64; ++d) o[d] = 0.f;
    { const int lo = tb * 128 - 255, kt_lo = lo > 0 ? (lo >> 6) : 0, kt_hi = 2 * tb + 1;
      for (int kt = kt_lo; kt <= kt_hi; ++kt) {
        __syncthreads();
        stage_kv64(Ks, Vs, PROJ + ((size_t)b * T_ + kt * 64) * NPROJ + EC_KWN + g * 64, PROJ + ((size_t)b * T_ + kt * 64) * NPROJ + EC_VWN + g * 64, NPROJ, tid);
        __syncthreads();
        if (kt * 64 <= t && kt * 64 + 63 > t - 256) {
            for (int j0 = 0; j0 < 64; j0 += 4) { float x[4]; bool ok[4];
#pragma unroll
                for (int i = 0; i < 4; ++i) { const int s = kt * 64 + j0 + i; ok[i] = (s <= t) && (t - s < 256); const int dist = ok[i] ? t - s : 0; x[i] = dot64p(q, Ks + (j0 + i) * 64) + bd[dist < 128 ? dist : 128]; }
                osm4(m, l, o, x, ok, Vs + j0 * 64); }
        }
      } }
    { const float s2 = g2 / l;
#pragma unroll
      for (int d = 0; d < 64; d += 4) { const f32x4 v = *(const f32x4*)(OF + d); o[d] = v[0] + s2 * o[d]; o[d + 1] = v[1] + s2 * o[d + 1]; o[d + 2] = v[2] + s2 * o[d + 2]; o[d + 3] = v[3] + s2 * o[d + 3]; } }
    store_o64(AO + row * 1024 + 512 + h * 64, o, 1.0f);
}
__device__ __forceinline__ void xattn_naive_unit(unsigned char* ws, LAS unsigned char* lds, int u, int tid) {
    const int b = u >> 5, xh = (u >> 3) & 3, qb = u & 7, tl = tid >> 1, half = tid & 1, t = qb * 256 + tl; const size_t row = (size_t)b * T_ + t;
    LAS float* Ks = (LAS float*)lds; LAS float* Vs = Ks + 8192;
    const bf16* QX = (const bf16*)(ws + WS_QX); bf16* AOX = (bf16*)(ws + WS_AOX); const bf16* KV = (const bf16*)(ws + WS_MEMKV) + (size_t)b * MEMLEN_ * 1024;
    float q[64], o[64]; load_q64(QX + row * 512 + xh * 128 + half * 64, q);
#pragma unroll
    for (int d = 0; d < 64; ++d) o[d] = 0.f;
    float m = NEGBIG, l = 0.f;
    for (int kt = 0; kt < 4; ++kt) {
        __syncthreads();
        { const int key = tid >> 3, d0 = (tid & 7) * 16; float kf[8], vf[8];
#pragma unroll
          for (int hh = 0; hh < 2; ++hh) { ld8(KV + (size_t)(kt * 64 + key) * 1024 + xh * 128 + d0 + hh * 8, kf); ld8(KV + (size_t)(kt * 64 + key) * 1024 + 512 + xh * 128 + d0 + hh * 8, vf);
#pragma unroll
            for (int i = 0; i < 8; ++i) { Ks[key * 128 + d0 + hh * 8 + i] = kf[i]; Vs[key * 128 + d0 + hh * 8 + i] = vf[i]; } } }
        __syncthreads();
        for (int j0 = 0; j0 < 64; j0 += 4) { float x[4]; bool ok[4];
#pragma unroll
            for (int i = 0; i < 4; ++i) { float part = 0.f; const LAS float* k = Ks + (j0 + i) * 128 + half * 64;
#pragma unroll
                for (int d = 0; d < 64; d += 4) { const f32x4 kv = *(const LAS f32x4*)(k + d); part += (q[d] * kv[0] + q[d + 1] * kv[1]) + (q[d + 2] * kv[2] + q[d + 3] * kv[3]); }
                x[i] = part + __shfl_xor(part, 1); ok[i] = true; }
            float mn = m;
#pragma unroll
            for (int i = 0; i < 4; ++i) mn = fmaxf(mn, x[i]);
            const float sc = exp2f(m - mn); float p[4];
#pragma unroll
            for (int i = 0; i < 4; ++i) p[i] = exp2f(x[i] - mn);
            l = l * sc + ((p[0] + p[1]) + (p[2] + p[3])); m = mn;
            const LAS float* v = Vs + j0 * 128 + half * 64;
#pragma unroll
            for (int d = 0; d < 64; d += 4) { const f32x4 v0 = *(const LAS f32x4*)(v + d), v1 = *(const LAS f32x4*)(v + 128 + d), v2 = *(const LAS f32x4*)(v + 256 + d), v3 = *(const LAS f32x4*)(v + 384 + d);
#pragma unroll
                for (int i = 0; i < 4; ++i) o[d + i] = o[d + i] * sc + (p[0] * v0[i] + p[1] * v1[i]) + (p[2] * v2[i] + p[3] * v3[i]); }
        }
    }
    store_o64(AOX + row * 512 + xh * 128 + half * 64, o, 1.0f / l);
}
namespace at {
typedef short bf16x8 __attribute__((ext_vector_type(8)));
typedef short s16x4 __attribute__((ext_vector_type(4)));
typedef short v4i16_t __attribute__((ext_vector_type(4)));
typedef float f32x16 __attribute__((ext_vector_type(16)));
typedef float f32x2_t __attribute__((ext_vector_type(2)));
typedef __bf16 bf16x2_t __attribute__((ext_vector_type(2)));
typedef LAS unsigned char* ldsp;
typedef const LAS unsigned char* cldsp;
constexpr float NINF = -INFINITY;
#if defined(SUBPROBE)
__device__ __forceinline__ void pr_mark(LAS unsigned char* lds, int i) { if (threadIdx.x == 0) { LAS unsigned long long* a = (LAS unsigned long long*)(lds + LDSCTL_OFF); const unsigned long long now = __builtin_amdgcn_s_memrealtime(); if (i >= 0) a[i] += now - a[4]; a[4] = now; } }
#define PR_MARK(i) at::pr_mark(lds, (i))
#else
#define PR_MARK(i) do {} while (0)
#endif
__device__ __forceinline__ unsigned cvtpk(float lo, float hi) { f32x2_t v = {lo, hi}; bf16x2_t b = __builtin_convertvector(v, bf16x2_t); return __builtin_bit_cast(unsigned, b); }
__device__ __forceinline__ s16x4 vtr(cldsp p) { return __builtin_bit_cast(s16x4, __builtin_amdgcn_ds_read_tr16_b64_v4i16((LAS v4i16_t*)p)); }
__device__ __forceinline__ float xhalf_max(float v) { auto rr = __builtin_amdgcn_permlane32_swap(__float_as_uint(v), __float_as_uint(v), false, false); return fmaxf(__uint_as_float(rr[0]), __uint_as_float(rr[1])); }
__device__ __forceinline__ float xhalf_sum(float v) { auto rr = __builtin_amdgcn_permlane32_swap(__float_as_uint(v), __float_as_uint(v), false, false); return __uint_as_float(rr[0]) + __uint_as_float(rr[1]); }
__device__ __forceinline__ bool wave_any(bool p) { return __builtin_amdgcn_ballot_w64(p) != 0ull; }
struct Stage { v4u k, v; };
__device__ __forceinline__ void ld_tile(Stage& s, const bf16* Kb, const bf16* Vb, int pitch, int wave, int lane) {
    const size_t off = (size_t)(8 * wave + (lane & 7)) * pitch + (lane >> 3) * 8;
    s.k = *(const v4u*)(Kb + off); s.v = *(const v4u*)(Vb + off);
}
__device__ __forceinline__ void st_tile(const Stage& s, ldsp Kslot, ldsp Vslot, int wave, int lane) {
    const int row = 8 * wave + (lane & 7), c = lane >> 3;
    *(LAS v4u*)(Kslot + c * 1024 + row * 16) = s.k; *(LAS v4u*)(Vslot + (c >> 2) * 4096 + row * 64 + (c & 3) * 16) = s.v;
}
__device__ __forceinline__ void qk64(f32x16& S0, f32x16& S1, cldsp Kslot, const bf16x8 (&qr)[4], int r32, int hi) {
    cldsp kb = Kslot + hi * 1024 + r32 * 16;
#pragma unroll
    for (int d0 = 0; d0 < 4; ++d0) { const bf16x8 b0 = *(const LAS bf16x8*)(kb + d0 * 2048), b1 = *(const LAS bf16x8*)(kb + d0 * 2048 + 512);
        S0 = __builtin_amdgcn_mfma_f32_32x32x16_bf16(b0, qr[d0], S0, 0, 0, 0); S1 = __builtin_amdgcn_mfma_f32_32x32x16_bf16(b1, qr[d0], S1, 0, 0, 0); }
}
__device__ __forceinline__ void qk64_c(f32x16& S0, f32x16& S1, cldsp Kslot, const bf16x8 (&qr)[4], const f32x16& C, int r32, int hi) {
    cldsp kb = Kslot + hi * 1024 + r32 * 16;
    { const bf16x8 b0 = *(const LAS bf16x8*)(kb), b1 = *(const LAS bf16x8*)(kb + 512);
      S0 = __builtin_amdgcn_mfma_f32_32x32x16_bf16(b0, qr[0], C, 0, 0, 0); S1 = __builtin_amdgcn_mfma_f32_32x32x16_bf16(b1, qr[0], C, 0, 0, 0); }
#pragma unroll
    for (int d0 = 1; d0 < 4; ++d0) { const bf16x8 b0 = *(const LAS bf16x8*)(kb + d0 * 2048), b1 = *(const LAS bf16x8*)(kb + d0 * 2048 + 512);
        S0 = __builtin_amdgcn_mfma_f32_32x32x16_bf16(b0, qr[d0], S0, 0, 0, 0); S1 = __builtin_amdgcn_mfma_f32_32x32x16_bf16(b1, qr[d0], S1, 0, 0, 0); }
}
__device__ __forceinline__ void pv64(f32x16 (&o)[2], cldsp vb, const v4u (&pa)[4]) {
#pragma unroll
    for (int db = 0; db < 2; ++db)
#pragma unroll
        for (int s = 0; s < 4; ++s) { const s16x4 lo = vtr(vb + db * 4096 + s * 1024), hi4 = vtr(vb + db * 4096 + s * 1024 + 512);
            const bf16x8 vf = {lo[0], lo[1], lo[2], lo[3], hi4[0], hi4[1], hi4[2], hi4[3]};
            o[db] = __builtin_amdgcn_mfma_f32_32x32x16_bf16(__builtin_bit_cast(bf16x8, pa[s]), vf, o[db], 0, 0, 0); }
}
struct Frags { bf16x8 kf[8]; s16x4 vlo[8], vhi[8]; };
__device__ __forceinline__ void load_frags(Frags& f, cldsp Kslot, cldsp vb, int r32, int hi) {
    cldsp kb = Kslot + hi * 1024 + r32 * 16;
#pragma unroll
    for (int d0 = 0; d0 < 4; ++d0) { f.kf[2 * d0] = *(const LAS bf16x8*)(kb + d0 * 2048); f.kf[2 * d0 + 1] = *(const LAS bf16x8*)(kb + d0 * 2048 + 512); }
#pragma unroll
    for (int i = 0; i < 8; ++i) { f.vlo[i] = vtr(vb + (i >> 2) * 4096 + (i & 3) * 1024); f.vhi[i] = vtr(vb + (i >> 2) * 4096 + (i & 3) * 1024 + 512); }
    __builtin_amdgcn_sched_barrier(0);
}
__device__ __forceinline__ void qk_mfma(f32x16& S0, f32x16& S1, const Frags& f, const bf16x8 (&qr)[4]) {
#pragma unroll
    for (int d0 = 0; d0 < 4; ++d0) { S0 = __builtin_amdgcn_mfma_f32_32x32x16_bf16(f.kf[2 * d0], qr[d0], S0, 0, 0, 0); S1 = __builtin_amdgcn_mfma_f32_32x32x16_bf16(f.kf[2 * d0 + 1], qr[d0], S1, 0, 0, 0); }
}
__device__ __forceinline__ void qk_mfma_c(f32x16& S0, f32x16& S1, const Frags& f, const bf16x8 (&qr)[4], const f32x16& C) {
    S0 = __builtin_amdgcn_mfma_f32_32x32x16_bf16(f.kf[0], qr[0], C, 0, 0, 0); S1 = __builtin_amdgcn_mfma_f32_32x32x16_bf16(f.kf[1], qr[0], C, 0, 0, 0);
#pragma unroll
    for (int d0 = 1; d0 < 4; ++d0) { S0 = __builtin_amdgcn_mfma_f32_32x32x16_bf16(f.kf[2 * d0], qr[d0], S0, 0, 0, 0); S1 = __builtin_amdgcn_mfma_f32_32x32x16_bf16(f.kf[2 * d0 + 1], qr[d0], S1, 0, 0, 0); }
}
__device__ __forceinline__ void pv_mfma(f32x16 (&o)[2], const Frags& f, const v4u (&pa)[4]) {
#pragma unroll
    for (int db = 0; db < 2; ++db)
#pragma unroll
        for (int sx = 0; sx < 4; ++sx) { const s16x4 lo = f.vlo[db * 4 + sx], hi4 = f.vhi[db * 4 + sx];
            const bf16x8 vf = {lo[0], lo[1], lo[2], lo[3], hi4[0], hi4[1], hi4[2], hi4[3]};
            o[db] = __builtin_amdgcn_mfma_f32_32x32x16_bf16(__builtin_bit_cast(bf16x8, pa[sx]), vf, o[db], 0, 0, 0); }
}
__device__ __forceinline__ int vbase(int lane) { return ((lane >> 4) & 1) * 32 + (lane & 3) * 8 + (4 * (lane >> 5) + ((lane & 15) >> 2)) * 64; }
template <int NDB> __device__ __forceinline__ void rows_scale(f32x16 (&o)[NDB], float v, LAS float* wsf, int r32, int hi) {
    if (hi == 0) wsf[r32] = v;
#pragma unroll
    for (int g = 0; g < 4; ++g) { const f32x4 a4 = *(const LAS f32x4*)(wsf + 8 * g + 4 * hi);
#pragma unroll
        for (int i = 0; i < 4; ++i) {
#pragma unroll
            for (int db = 0; db < NDB; ++db) o[db][4 * g + i] *= a4[i]; } }
}
template <bool FIRST> __device__ __forceinline__ void rows_fma(LAS float* ofl, const f32x16 (&o)[2], float v, LAS float* wsf, int r32, int hi, int lane) {
    if (hi == 0) wsf[r32] = v;
#pragma unroll
    for (int g = 0; g < 4; ++g) { const f32x4 a4 = *(const LAS f32x4*)(wsf + 8 * g + 4 * hi);
#pragma unroll
        for (int i = 0; i < 4; ++i) {
#pragma unroll
            for (int db = 0; db < 2; ++db) { LAS float* p = ofl + (db * 16 + 4 * g + i) * 64 + lane; const float x = o[db][4 * g + i] * a4[i]; *p = FIRST ? x : (*p + x); } } }
}
template <int NDB> __device__ __forceinline__ void osm64(f32x16& S0, f32x16& S1, float& m, float& l, f32x16 (&o)[NDB], LAS float* wsf, int r32, int hi, v4u (&pa)[4]) {
    float mt = fmaxf(S0[0], S1[0]);
#pragma unroll
    for (int r = 1; r < 16; ++r) mt = fmaxf(mt, fmaxf(S0[r], S1[r]));
    mt = xhalf_max(mt);
    const float mn = fmaxf(m, mt);
    if (wave_any(mn > m)) {
        const float msn = (mn == NINF) ? 0.f : mn;
        const float alpha = __builtin_amdgcn_exp2f(m - msn);
        l *= alpha; m = mn;
        rows_scale<NDB>(o, alpha, wsf, r32, hi);
    }
    const float ms = (m == NINF) ? 0.f : m;
    float ls = 0.f;
#pragma unroll
    for (int r = 0; r < 16; ++r) { S0[r] = __builtin_amdgcn_exp2f(S0[r] - ms); S1[r] = __builtin_amdgcn_exp2f(S1[r] - ms); ls += S0[r] + S1[r]; }
    l += ls;
    pa[0] = (v4u){cvtpk(S0[0], S0[1]), cvtpk(S0[2], S0[3]), cvtpk(S0[4], S0[5]), cvtpk(S0[6], S0[7])};
    pa[1] = (v4u){cvtpk(S0[8], S0[9]), cvtpk(S0[10], S0[11]), cvtpk(S0[12], S0[13]), cvtpk(S0[14], S0[15])};
    pa[2] = (v4u){cvtpk(S1[0], S1[1]), cvtpk(S1[2], S1[3]), cvtpk(S1[4], S1[5]), cvtpk(S1[6], S1[7])};
    pa[3] = (v4u){cvtpk(S1[8], S1[9]), cvtpk(S1[10], S1[11]), cvtpk(S1[12], S1[13]), cvtpk(S1[14], S1[15])};
}
constexpr float SM_THR = 8.0f;
struct SoftState { float nm, l; };
__device__ __forceinline__ void sm_init(SoftState& st, float base) { st.nm = base; st.l = 0.f; }
__device__ __forceinline__ f32x16 sm_tuple(const SoftState& st) { f32x16 c;
#pragma unroll
    for (int r = 0; r < 16; ++r) c[r] = st.nm;
    return c; }
#define MX3(a, b, c) __builtin_fmaxf(__builtin_fmaxf((a), (b)), (c))
template <int NDB> __device__ __forceinline__ void osm_lag(f32x16& S0, f32x16& S1, SoftState& st, bool first, f32x16 (&o)[NDB], LAS float* wsf, int r32, int hi, v4u (&pa)[4], bool live = true) {
    float a = MX3(S0[0], S0[1], S1[0]), b = MX3(S0[2], S0[3], S1[1]); a = MX3(a, S1[2], S1[3]);
#pragma unroll
    for (int r = 4; r < 16; r += 4) { a = MX3(a, S0[r], S0[r + 1]); b = MX3(b, S0[r + 2], S0[r + 3]); a = MX3(a, S1[r], S1[r + 1]); b = MX3(b, S1[r + 2], S1[r + 3]); }
    const float rm = live ? xhalf_max(__builtin_fmaxf(a, b)) : NINF;
    if (first || wave_any(rm > SM_THR)) {
        const float dl = first ? (rm > -1.0e30f ? rm : 0.f) : __builtin_fmaxf(rm, 0.f);
        st.nm -= dl;
#pragma unroll
        for (int r = 0; r < 16; ++r) { S0[r] -= dl; S1[r] -= dl; }
        const float f = __builtin_amdgcn_exp2f(-dl); st.l *= f;
        if (!first) rows_scale<NDB>(o, f, wsf, r32, hi);
    }
    float ls = 0.f;
#pragma unroll
    for (int r = 0; r < 16; ++r) { S0[r] = __builtin_amdgcn_exp2f(S0[r]); S1[r] = __builtin_amdgcn_exp2f(S1[r]); ls += S0[r] + S1[r]; }
    st.l += live ? ls : 0.f;
    const unsigned lm = live ? 0xffffffffu : 0u;
    pa[0] = (v4u){cvtpk(S0[0], S0[1]) & lm, cvtpk(S0[2], S0[3]) & lm, cvtpk(S0[4], S0[5]) & lm, cvtpk(S0[6], S0[7]) & lm};
    pa[1] = (v4u){cvtpk(S0[8], S0[9]) & lm, cvtpk(S0[10], S0[11]) & lm, cvtpk(S0[12], S0[13]) & lm, cvtpk(S0[14], S0[15]) & lm};
    pa[2] = (v4u){cvtpk(S1[0], S1[1]) & lm, cvtpk(S1[2], S1[3]) & lm, cvtpk(S1[4], S1[5]) & lm, cvtpk(S1[6], S1[7]) & lm};
    pa[3] = (v4u){cvtpk(S1[8], S1[9]) & lm, cvtpk(S1[10], S1[11]) & lm, cvtpk(S1[12], S1[13]) & lm, cvtpk(S1[14], S1[15]) & lm};
}
template <int NDB> __device__ __forceinline__ void osm_lag2(f32x16& S0, f32x16& S1, f32x16& S2, f32x16& S3, SoftState& st, bool first, f32x16 (&o)[NDB], LAS float* wsf, int r32, int hi, v4u (&pa)[8]) {
    float a = MX3(S0[0], S0[1], S1[0]), b = MX3(S0[2], S0[3], S1[1]), c = MX3(S2[0], S2[1], S3[0]), d = MX3(S2[2], S2[3], S3[1]); a = MX3(a, S1[2], S1[3]); c = MX3(c, S3[2], S3[3]);
#pragma unroll
    for (int r = 4; r < 16; r += 4) { a = MX3(a, S0[r], S0[r + 1]); b = MX3(b, S0[r + 2], S0[r + 3]); a = MX3(a, S1[r], S1[r + 1]); b = MX3(b, S1[r + 2], S1[r + 3]);
        c = MX3(c, S2[r], S2[r + 1]); d = MX3(d, S2[r + 2], S2[r + 3]); c = MX3(c, S3[r], S3[r + 1]); d = MX3(d, S3[r + 2], S3[r + 3]); }
    const float rm = xhalf_max(__builtin_fmaxf(__builtin_fmaxf(a, b), __builtin_fmaxf(c, d)));
    if (first || wave_any(rm > SM_THR)) {
        const float dl = first ? (rm > -1.0e30f ? rm : 0.f) : __builtin_fmaxf(rm, 0.f);
        st.nm -= dl;
#pragma unroll
        for (int r = 0; r < 16; ++r) { S0[r] -= dl; S1[r] -= dl; S2[r] -= dl; S3[r] -= dl; }
        const float f = __builtin_amdgcn_exp2f(-dl); st.l *= f;
        if (!first) rows_scale<NDB>(o, f, wsf, r32, hi);
    }
    float ls = 0.f, ls2 = 0.f;
#pragma unroll
    for (int r = 0; r < 16; ++r) { S0[r] = __builtin_amdgcn_exp2f(S0[r]); S1[r] = __builtin_amdgcn_exp2f(S1[r]); S2[r] = __builtin_amdgcn_exp2f(S2[r]); S3[r] = __builtin_amdgcn_exp2f(S3[r]); ls += S0[r] + S1[r]; ls2 += S2[r] + S3[r]; }
    st.l += ls + ls2;
    pa[0] = (v4u){cvtpk(S0[0], S0[1]), cvtpk(S0[2], S0[3]), cvtpk(S0[4], S0[5]), cvtpk(S0[6], S0[7])};
    pa[1] = (v4u){cvtpk(S0[8], S0[9]), cvtpk(S0[10], S0[11]), cvtpk(S0[12], S0[13]), cvtpk(S0[14], S0[15])};
    pa[2] = (v4u){cvtpk(S1[0], S1[1]), cvtpk(S1[2], S1[3]), cvtpk(S1[4], S1[5]), cvtpk(S1[6], S1[7])};
    pa[3] = (v4u){cvtpk(S1[8], S1[9]), cvtpk(S1[10], S1[11]), cvtpk(S1[12], S1[13]), cvtpk(S1[14], S1[15])};
    pa[4] = (v4u){cvtpk(S2[0], S2[1]), cvtpk(S2[2], S2[3]), cvtpk(S2[4], S2[5]), cvtpk(S2[6], S2[7])};
    pa[5] = (v4u){cvtpk(S2[8], S2[9]), cvtpk(S2[10], S2[11]), cvtpk(S2[12], S2[13]), cvtpk(S2[14], S2[15])};
    pa[6] = (v4u){cvtpk(S3[0], S3[1]), cvtpk(S3[2], S3[3]), cvtpk(S3[4], S3[5]), cvtpk(S3[6], S3[7])};
    pa[7] = (v4u){cvtpk(S3[8], S3[9]), cvtpk(S3[10], S3[11]), cvtpk(S3[12], S3[13]), cvtpk(S3[14], S3[15])};
}
template <int NDB> __device__ __forceinline__ void emit_o(const LAS float* stg, bf16* Ow, int pitch, int lane) {
#pragma unroll
    for (int i = 0; i < NDB * 2; ++i) { const int p = i * 64 + lane, c = p % (NDB * 4), q = p / (NDB * 4);
        const int db = c >> 2, col0 = (c & 3) * 8, r = (q & 3) + 4 * (q >> 3), hq = (q >> 2) & 1;
        const LAS float* src = stg + (db * 16 + r) * 64 + hq * 32 + col0; const f32x4 a = *(const LAS f32x4*)src, b = *(const LAS f32x4*)(src + 4);
        *(v4u*)(Ow + (size_t)q * pitch + c * 8) = (v4u){pk2(a[0], a[1]), pk2(a[2], a[3]), pk2(b[0], b[1]), pk2(b[2], b[3])}; }
}
template <int NDB> __device__ __forceinline__ void store_o(const f32x16 (&o)[NDB], LAS float* stg, bf16* Ow, int pitch, int lane) {
#pragma unroll
    for (int db = 0; db < NDB; ++db)
#pragma unroll
        for (int r = 0; r < 16; ++r) stg[(db * 16 + r) * 64 + lane] = o[db][r];
    asm volatile("s_waitcnt lgkmcnt(0)" ::: "memory");
    emit_o<NDB>(stg, Ow, pitch, lane);
}
__device__ __forceinline__ void load_q(bf16x8 (&qr)[4], const bf16* Qw, int pitch, int r32, int hi) {
#pragma unroll
    for (int d0 = 0; d0 < 4; ++d0) qr[d0] = *(const bf16x8*)(Qw + (size_t)r32 * pitch + d0 * 16 + hi * 8);
}
__device__ __forceinline__ void mask_causal(f32x16& S0, f32x16& S1, int tq, int hi) {
    asm volatile("" : "+v"(tq), "+v"(hi));
#pragma unroll
    for (int r = 0; r < 16; ++r) { const int k = (r & 3) + 8 * (r >> 2) + 4 * hi; if (k > tq) S0[r] = NINF; if (k + 32 > tq) S1[r] = NINF; }
}

constexpr int FX_FS = 0, FX_TOT = 8192, FX_K = 16384, FX_V = 49152, FX_WSF = 81920;
__device__ __forceinline__ void fox_unit(unsigned char* ws, ldsp lds, int b, int h, int qb, int tid) {
    const int lane = tid & 63, wave = __builtin_amdgcn_readfirstlane(tid >> 6), r32 = lane & 31, hi = lane >> 5;
    LAS float* Fs = (LAS float*)(lds + FX_FS); LAS float* tot = (LAS float*)(lds + FX_TOT); LAS float* wsf = (LAS float*)(lds + FX_WSF) + wave * 32;
    const bf16* PROJ = (const bf16*)(ws + WS_PROJ); bf16* AO = (bf16*)(ws + WS_AO);
    const float* lf = (const float*)(ws + WS_LF) + (size_t)(b * 8 + h) * 2048;
    const size_t row0 = (size_t)b * T_;
    const int q0 = qb * 256 + wave * 32;
    const f32x4 lfv = *(const f32x4*)(lf + 4 * tid);
    bf16x8 qr[4]; load_q(qr, PROJ + (row0 + q0) * NPROJ + EC_FQ + h * 64, NPROJ, r32, hi);
    const bf16* Kg = PROJ + row0 * NPROJ + EC_FK + h * 64; const bf16* Vg = PROJ + row0 * NPROJ + EC_FV + h * 64;
    const int ntile = 4 * qb + 4, my_last = 4 * qb + (wave >> 1), nstep = ntile / 2;
    struct Stage2 { Stage a, b; };
    Stage2 st; ld_tile(st.a, Kg + (size_t)(ntile - 1) * 64 * NPROJ, Vg + (size_t)(ntile - 1) * 64 * NPROJ, NPROJ, wave, lane); ld_tile(st.b, Kg + (size_t)(ntile - 2) * 64 * NPROJ, Vg + (size_t)(ntile - 2) * 64 * NPROJ, NPROJ, wave, lane);
    __syncthreads();
    {
      const float p0 = lfv[0], p1 = p0 + lfv[1], p2 = p1 + lfv[2], p3 = p2 + lfv[3];
      LAS float* wt = tot + wave * 128;
      wt[lane] = p3; int cur = 0; asm volatile("s_waitcnt lgkmcnt(0)" ::: "memory");
#pragma unroll
      for (int off = 1; off < 64; off <<= 1) { float x = wt[cur * 64 + lane]; if (lane >= off) x += wt[cur * 64 + lane - off]; wt[(cur ^ 1) * 64 + lane] = x; cur ^= 1; asm volatile("s_waitcnt lgkmcnt(0)" ::: "memory"); }
      const float incl = wt[cur * 64 + lane];
      if (lane == 63) tot[1024 + wave] = incl;
      __syncthreads();
      float base = 0.f;
#pragma unroll
      for (int w = 0; w < 8; ++w) base += (w < wave) ? tot[1024 + w] : 0.f;
      const float ex = base + incl - p3; *(LAS f32x4*)(Fs + 4 * tid) = (f32x4){-(ex + p0), -(ex + p1), -(ex + p2), -(ex + p3)}; }
    f32x16 o[2]; o[0] = (f32x16){0}; o[1] = (f32x16){0};
    SoftState sm; sm_init(sm, 0.f);
    const int vb = vbase(lane);
    auto ld2 = [&](Stage2& st, int T) __attribute__((always_inline)) { ld_tile(st.a, Kg + (size_t)(2 * T + 1) * 64 * NPROJ, Vg + (size_t)(2 * T + 1) * 64 * NPROJ, NPROJ, wave, lane); ld_tile(st.b, Kg + (size_t)(2 * T) * 64 * NPROJ, Vg + (size_t)(2 * T) * 64 * NPROJ, NPROJ, wave, lane); };
    auto fs_init = [&](f32x16& S0, f32x16& S1, int kt, float nm) __attribute__((always_inline)) {
#pragma unroll
        for (int g = 0; g < 4; ++g) { const f32x4 a = *(const LAS f32x4*)(Fs + kt * 64 + 8 * g + 4 * hi), c = *(const LAS f32x4*)(Fs + kt * 64 + 32 + 8 * g + 4 * hi);
#pragma unroll
            for (int i = 0; i < 4; ++i) { S0[4 * g + i] = a[i] + nm; S1[4 * g + i] = c[i] + nm; } } };
    for (int T = nstep - 1; T >= 0; --T) {
        const int slot = T & 1; ldsp KsA = lds + FX_K + slot * 16384, KsB = KsA + 8192, VsA = lds + FX_V + slot * 16384, VsB = VsA + 8192;
        st_tile(st.a, KsA, VsA, wave, lane); st_tile(st.b, KsB, VsB, wave, lane);
        __syncthreads();
        if (T >= 1) ld2(st, T - 1);
        if (2 * T <= my_last) {
            const bool hasA = 2 * T + 1 <= my_last; const float nm = sm.nm;
            f32x16 S0, S1, S2, S3;
            fs_init(S2, S3, 2 * T, nm); qk64(S2, S3, KsB, qr, r32, hi);
            if (hasA) { fs_init(S0, S1, 2 * T + 1, nm); qk64(S0, S1, KsA, qr, r32, hi); }
            else {
#pragma unroll
                for (int r = 0; r < 16; ++r) { S0[r] = NINF; S1[r] = NINF; } }
            if (2 * T + 1 == my_last) mask_causal(S0, S1, (wave & 1) * 32 + r32, hi);
            if (2 * T == my_last) mask_causal(S2, S3, (wave & 1) * 32 + r32, hi);
            v4u pa[8]; osm_lag2<2>(S0, S1, S2, S3, sm, (my_last >> 1) == T, o, wsf, r32, hi, pa);
            const v4u (&paA)[4] = *(const v4u (*)[4])&pa[0]; const v4u (&paB)[4] = *(const v4u (*)[4])&pa[4];
            if (hasA) pv64(o, VsA + vb, paA);
            pv64(o, VsB + vb, paB);
        }
    }
    { const float l = xhalf_sum(sm.l); rows_scale<2>(o, 1.0f / l, wsf, r32, hi); }
    __syncthreads();
    store_o<2>(o, (LAS float*)(lds + FX_K) + wave * 2048, AO + (row0 + q0) * 1024 + h * 64, 1024, lane);
}

constexpr int SB_K = 0, SB_V = 32768, SB_FLAG = 132096;
__device__ __forceinline__ void sb_unit(unsigned char* ws, ldsp lds, int b, int hp, int qb, int tid) {
    const int lane = tid & 63, wave = __builtin_amdgcn_readfirstlane(tid >> 6), r32 = lane & 31, hi = lane >> 5, hj = wave >> 2, sub = wave & 3, h = hp * 2 + hj;
    const bf16* PROJ = (const bf16*)(ws + WS_PROJ); bf16* AO = (bf16*)(ws + WS_AO);
    LAS unsigned* dflag = (LAS unsigned*)(lds + SB_FLAG);
    const size_t row0 = (size_t)b * T_; const int q0 = qb * 128 + sub * 32;
    __syncthreads();
    if (lane == 0) { dflag[wave] = 0u; dflag[8 + wave] = 0u; }
    bf16x8 qr[4]; load_q(qr, PROJ + (row0 + q0) * NPROJ + OC_SQ + h * 64, NPROJ, r32, hi);
    const bf16* Kg = PROJ + row0 * NPROJ + OC_SK + hp * 128; const bf16* Vg = PROJ + row0 * NPROJ + OC_SV + hp * 128;
    f32x16 o[2]; o[0] = (f32x16){0}; o[1] = (f32x16){0};
    float carry = 1.0f; bool done = false;
    const int vb = vbase(lane), tq = (sub & 1) * 32 + r32, kd = 2 * qb + (sub >> 1), ktop = 2 * qb + 1;
    auto step = [&](Stage (&st)[2], int kt, int buf) __attribute__((always_inline)) -> bool {
#pragma unroll
        for (int j = 0; j < 2; ++j) st_tile(st[j], lds + SB_K + buf * 16384 + j * 8192, lds + SB_V + buf * 16384 + j * 8192, wave, lane);
        __syncthreads();
        { LAS unsigned* fr = dflag + (buf ^ 1) * 8; const unsigned f0 = fr[0] & fr[1] & fr[2] & fr[3] & fr[4] & fr[5] & fr[6] & fr[7]; if (f0) return true; }
        if (kt >= 2) {
#pragma unroll
            for (int j = 0; j < 2; ++j) ld_tile(st[j], Kg + (size_t)(kt - 2) * 64 * NPROJ + j * 64, Vg + (size_t)(kt - 2) * 64 * NPROJ + j * 64, NPROJ, wave, lane);
        }
        if (!done && kt <= kd) {
            ldsp Ks = lds + SB_K + buf * 16384 + hj * 8192; ldsp Vs = lds + SB_V + buf * 16384 + hj * 8192;
            f32x16 Y0 = (f32x16){0}, Y1 = (f32x16){0};
            qk64(Y0, Y1, Ks, qr, r32, hi);
            f32x16 C0, C1;
#pragma unroll
            for (int r = 0; r < 16; ++r) { const float u0 = __builtin_amdgcn_exp2f(fminf(Y0[r], 80.f)), u1 = __builtin_amdgcn_exp2f(fminf(Y1[r], 80.f));
                C0[r] = __builtin_amdgcn_rcpf(1.0f + u0); C1[r] = __builtin_amdgcn_rcpf(1.0f + u1); Y0[r] = u0 * C0[r]; Y1[r] = u1 * C1[r]; }
            if (kt == kd) { int tq_ = tq, hi_ = hi; asm volatile("" : "+v"(tq_), "+v"(hi_));
#pragma unroll
                for (int r = 0; r < 16; ++r) { const int k = (r & 3) + 8 * (r >> 2) + 4 * hi_; if (k >= tq_) { C0[r] = 1.0f; Y0[r] = 0.f; } if (k + 32 >= tq_) { C1[r] = 1.0f; Y1[r] = 0.f; } }
            }
            float gp[16];
#pragma unroll
            for (int g = 0; g < 4; ++g) {
                const float p0 = (C0[4 * g] * C0[4 * g + 1]) * (C0[4 * g + 2] * C0[4 * g + 3]), p1 = (C1[4 * g] * C1[4 * g + 1]) * (C1[4 * g + 2] * C1[4 * g + 3]);
                auto r0 = __builtin_amdgcn_permlane32_swap(__float_as_uint(p0), __float_as_uint(p0), false, false); auto r1 = __builtin_amdgcn_permlane32_swap(__float_as_uint(p1), __float_as_uint(p1), false, false);
                gp[2 * g] = __uint_as_float(r0[0]); gp[2 * g + 1] = __uint_as_float(r0[1]); gp[8 + 2 * g] = __uint_as_float(r1[0]); gp[8 + 2 * g + 1] = __uint_as_float(r1[1]); }
            float suf[16]; suf[15] = carry;
#pragma unroll
            for (int G = 14; G >= 0; --G) suf[G] = suf[G + 1] * gp[G + 1];
            const float ncarry = suf[0] * gp[0];
#pragma unroll
            for (int g = 0; g < 4; ++g) {
                float la = hi ? suf[2 * g + 1] : suf[2 * g];
                { const float a3 = Y0[4 * g + 3] * la; la *= C0[4 * g + 3]; const float a2 = Y0[4 * g + 2] * la; la *= C0[4 * g + 2]; const float a1 = Y0[4 * g + 1] * la; la *= C0[4 * g + 1]; const float a0 = Y0[4 * g] * la;
                  Y0[4 * g] = a0; Y0[4 * g + 1] = a1; Y0[4 * g + 2] = a2; Y0[4 * g + 3] = a3; }
                float lb = hi ? suf[8 + 2 * g + 1] : suf[8 + 2 * g];
                { const float a3 = Y1[4 * g + 3] * lb; lb *= C1[4 * g + 3]; const float a2 = Y1[4 * g + 2] * lb; lb *= C1[4 * g + 2]; const float a1 = Y1[4 * g + 1] * lb; lb *= C1[4 * g + 1]; const float a0 = Y1[4 * g] * lb;
                  Y1[4 * g] = a0; Y1[4 * g + 1] = a1; Y1[4 * g + 2] = a2; Y1[4 * g + 3] = a3; }
            }
            carry = ncarry;
            v4u pa[4];
            pa[0] = (v4u){cvtpk(Y0[0], Y0[1]), cvtpk(Y0[2], Y0[3]), cvtpk(Y0[4], Y0[5]), cvtpk(Y0[6], Y0[7])};
            pa[1] = (v4u){cvtpk(Y0[8], Y0[9]), cvtpk(Y0[10], Y0[11]), cvtpk(Y0[12], Y0[13]), cvtpk(Y0[14], Y0[15])};
            pa[2] = (v4u){cvtpk(Y1[0], Y1[1]), cvtpk(Y1[2], Y1[3]), cvtpk(Y1[4], Y1[5]), cvtpk(Y1[6], Y1[7])};
            pa[3] = (v4u){cvtpk(Y1[8], Y1[9]), cvtpk(Y1[10], Y1[11]), cvtpk(Y1[12], Y1[13]), cvtpk(Y1[14], Y1[15])};
            pv64(o, Vs + vb, pa);
            if (!wave_any(carry > 1.0e-30f)) done = true;
        }
        if (lane == 0) dflag[buf * 8 + wave] = done ? 1u : 0u;
        return false;
    };
    Stage sa[2], sb[2];
#pragma unroll
    for (int j = 0; j < 2; ++j) { ld_tile(sa[j], Kg + (size_t)ktop * 64 * NPROJ + j * 64, Vg + (size_t)ktop * 64 * NPROJ + j * 64, NPROJ, wave, lane); ld_tile(sb[j], Kg + (size_t)(ktop - 1) * 64 * NPROJ + j * 64, Vg + (size_t)(ktop - 1) * 64 * NPROJ + j * 64, NPROJ, wave, lane); }
    for (int kt = ktop; kt > 0; kt -= 2) {
        if (step(sa, kt, 0)) break;
        if (step(sb, kt - 1, 1)) break;
    }
    __syncthreads();
    store_o<2>(o, (LAS float*)(lds + SB_K) + wave * 2048, AO + (row0 + q0) * 1024 + h * 64, 1024, lane);
}

constexpr int XA_K = 0, XA_V = 65536, XA_WSF = 132096;
__device__ __forceinline__ void xattn_unit(unsigned char* ws, ldsp lds, int b, int xh, int qb, int tid) {
    const int lane = tid & 63, wave = __builtin_amdgcn_readfirstlane(tid >> 6), r32 = lane & 31, hi = lane >> 5;
    const bf16* QX = (const bf16*)(ws + WS_QX); bf16* AOX = (bf16*)(ws + WS_AOX); const bf16* KV = (const bf16*)(ws + WS_MEMKV) + (size_t)b * MEMLEN_ * 1024 + xh * 128;
    LAS float* wsf = (LAS float*)(lds + XA_WSF) + wave * 32;
    __syncthreads();
#pragma unroll
    for (int i = 0; i < 8; ++i) { const int p = tid + 512 * i, c = p & 15, key = p >> 4;
        const v4u kk = *(const v4u*)(KV + (size_t)key * 1024 + c * 8), vv = *(const v4u*)(KV + (size_t)key * 1024 + 512 + c * 8);
        *(LAS v4u*)(lds + XA_K + (key >> 6) * 16384 + c * 1024 + (key & 63) * 16) = kk;
        *(LAS v4u*)(lds + XA_V + (key >> 6) * 16384 + (c >> 2) * 4096 + (key & 63) * 64 + (c & 3) * 16) = vv; }
    const size_t row0 = (size_t)b * T_; const int q0 = qb * 256 + wave * 32;
    bf16x8 qr[8];
#pragma unroll
    for (int d0 = 0; d0 < 8; ++d0) qr[d0] = *(const bf16x8*)(QX + (row0 + q0 + r32) * 512 + xh * 128 + d0 * 16 + hi * 8);
    f32x16 o[4];
#pragma unroll
    for (int db = 0; db < 4; ++db) o[db] = (f32x16){0};
    SoftState sm; sm_init(sm, 0.f); const int vb = vbase(lane);
    __syncthreads();
    for (int kt = 0; kt < 4; ++kt) {
        cldsp kb = lds + XA_K + kt * 16384 + hi * 1024 + r32 * 16; cldsp vs = lds + XA_V + kt * 16384 + vb;
        f32x16 S0 = sm_tuple(sm), S1 = S0;
#pragma unroll
        for (int d0 = 0; d0 < 8; ++d0) { const bf16x8 b0 = *(const LAS bf16x8*)(kb + d0 * 2048), b1 = *(const LAS bf16x8*)(kb + d0 * 2048 + 512);
            S0 = __builtin_amdgcn_mfma_f32_32x32x16_bf16(b0, qr[d0], S0, 0, 0, 0); S1 = __builtin_amdgcn_mfma_f32_32x32x16_bf16(b1, qr[d0], S1, 0, 0, 0); }
        v4u pa[4];
        osm_lag<4>(S0, S1, sm, kt == 0, o, wsf, r32, hi, pa);
#pragma unroll
        for (int db = 0; db < 4; ++db)
#pragma unroll
            for (int s = 0; s < 4; ++s) { const s16x4 lo = vtr(vs + db * 4096 + s * 1024), hi4 = vtr(vs + db * 4096 + s * 1024 + 512);
                const bf16x8 vf = {lo[0], lo[1], lo[2], lo[3], hi4[0], hi4[1], hi4[2], hi4[3]};
                o[db] = __builtin_amdgcn_mfma_f32_32x32x16_bf16(__builtin_bit_cast(bf16x8, pa[s]), vf, o[db], 0, 0, 0); }
    }
    { const float l = xhalf_sum(sm.l); rows_scale<4>(o, 1.0f / l, wsf, r32, hi); }
    __syncthreads();
    store_o<4>(o, (LAS float*)(lds + XA_K) + wave * 4096, AOX + (row0 + q0) * 512 + xh * 128, 512, lane);
}

constexpr int NS_K = 0, NS_V = 16384, NS_BD = 32768, NS_SLAB = 36864  , NS_SEL = 70144, NS_WSF = 70656, NS_OF = 73728;
template <int MODE> __device__ __forceinline__ void nsa_logits(f32x16& S0, f32x16& S1, int dq, int tq, int hi, const LAS float* bdh, bool sel) {
    asm volatile("" : "+v"(tq), "+v"(hi));
    if (dq < 3) {
#pragma unroll
        for (int r = 0; r < 16; ++r) { const int k = (r & 3) + 8 * (r >> 2) + 4 * hi; const unsigned d0 = (unsigned)(64 * dq + tq - k); S0[r] += bdh[d0 < 128u ? d0 : 128u]; }
#pragma unroll
        for (int r = 0; r < 16; ++r) { const int k = (r & 3) + 8 * (r >> 2) + 4 * hi; const unsigned d1 = (unsigned)(64 * dq + tq - k - 32); S1[r] += bdh[d1 < 128u ? d1 : 128u]; }
    }
    if (dq == 0) {
#pragma unroll
        for (int r = 0; r < 16; ++r) { const int k = (r & 3) + 8 * (r >> 2) + 4 * hi; if (k > tq) S0[r] = NINF; if (k + 32 > tq) S1[r] = NINF; }
    }
    if (MODE == 1 && dq == 4) {
#pragma unroll
        for (int r = 0; r < 16; ++r) { const int k = (r & 3) + 8 * (r >> 2) + 4 * hi; if (k <= tq) S0[r] = NINF; if (k + 32 <= tq) S1[r] = NINF; }
    }
}
__device__ __forceinline__ void cmp_logits(f32x16& S0, f32x16& S1, int ct, int t, int nvalid, int hi, const LAS float* bdh) {
    asm volatile("" : "+v"(t), "+v"(hi));
#pragma unroll
    for (int r = 0; r < 16; ++r) { const int c0 = 64 * ct + (r & 3) + 8 * (r >> 2) + 4 * hi; const unsigned d0 = (unsigned)(t - 31 - 16 * c0);
        const float b0 = bdh[d0 < 128u ? d0 : 128u]; S0[r] = c0 < nvalid ? S0[r] + b0 : NINF; }
#pragma unroll
    for (int r = 0; r < 16; ++r) { const int c1 = 64 * ct + 32 + (r & 3) + 8 * (r >> 2) + 4 * hi; const unsigned d1 = (unsigned)(t - 31 - 16 * c1);
        const float b1 = bdh[d1 < 128u ? d1 : 128u]; S1[r] = c1 < nvalid ? S1[r] + b1 : NINF; }
}
__device__ __forceinline__ void nsa_unit(const float* rel_bias, unsigned char* ws, ldsp lds, int b, int g, int qb, int tid) {
    const int lane = tid & 63, wave = __builtin_amdgcn_readfirstlane(tid >> 6), r32 = lane & 31, hi = lane >> 5, hj = wave >> 1, sub = wave & 1, h = g * 4 + hj;
    const bf16* PROJ = (const bf16*)(ws + WS_PROJ); bf16* AO = (bf16*)(ws + WS_AO);
    LAS float* bd = (LAS float*)(lds + NS_BD); LAS float* slab = (LAS float*)(lds + NS_SLAB); LAS unsigned* selm = (LAS unsigned*)(lds + NS_SEL); LAS float* wsf = (LAS float*)(lds + NS_WSF) + wave * 32;
    const size_t row0 = (size_t)b * T_; const int tq = sub * 32 + r32, t = qb * 64 + tq; const size_t row = row0 + t;
    __syncthreads();
    for (int i = tid; i < 4 * 130; i += NTHR) { const int rr = i / 130, dd = i % 130; const int bk = dd < 128 ? (int)T5_BUCKET[dd] : 31; const float far = rel_bias[31 * 8 + g * 4 + rr];
        bd[rr * 132 + dd] = dd < 129 ? (rel_bias[bk * 8 + g * 4 + rr] - far) * LOG2E : far * LOG2E; }
    const LAS float* bdh = bd + hj * 132;
    bf16x8 qr[4]; load_q(qr, PROJ + (row0 + qb * 64 + sub * 32) * NPROJ + EC_NQ + h * 64, NPROJ, r32, hi);
    const float* gt = (const float*)(ws + WS_GT) + row * 24 + h * 3;
    f32x16 o[2]; LAS float* ofl = (LAS float*)(lds + NS_OF) + wave * 2048;
    const int vb = vbase(lane);
    SoftState sm; float cbase;
    const int nvalid = t >= 31 ? ((t - 31) >> 4) + 1 : 0;
    const int nct = qb < 16 ? 1 : 2;
    const bf16* KCB = (const bf16*)(ws + WS_KCB) + (size_t)(b * 2 + g) * 128 * 64; const bf16* VCB = (const bf16*)(ws + WS_VCB) + (size_t)(b * 2 + g) * 128 * 64;
    { Stage st; ld_tile(st, KCB, VCB, 64, wave, lane); st_tile(st, lds + NS_K, lds + NS_V, wave, lane);
      if (nct > 1) { ld_tile(st, KCB + 64 * 64, VCB + 64 * 64, 64, wave, lane); st_tile(st, lds + NS_K + 8192, lds + NS_V + 8192, wave, lane); } }
    __syncthreads();
    cbase = bdh[129]; sm_init(sm, cbase); o[0] = (f32x16){0}; o[1] = (f32x16){0};
    for (int ct = 0; ct < nct; ++ct) {
        f32x16 S0, S1;
        S0 = sm_tuple(sm); S1 = S0; qk64(S0, S1, lds + NS_K + ct * 8192, qr, r32, hi);
        cmp_logits(S0, S1, ct, t, nvalid, hi, bdh);
        v4u pa[4]; osm_lag<2>(S0, S1, sm, ct == 0, o, wsf, r32, hi, pa);
        pv64(o, lds + NS_V + ct * 8192 + vb, pa);
    }
    const float lc = xhalf_sum(sm.l);
    const float il = lc > 0.f ? 1.0f / lc : 0.f;
    rows_fma<true>(ofl, o, gt[0] * il, wsf, r32, hi, lane);
    { float carry = 0.f;
      for (int ct = 0; ct < nct; ++ct) {
        f32x16 S0 = sm_tuple(sm), S1 = S0;
        qk64(S0, S1, lds + NS_K + ct * 8192, qr, r32, hi);
        cmp_logits(S0, S1, ct, t, nvalid, hi, bdh);
#pragma unroll
        for (int r = 0; r < 16; ++r) { S0[r] = __builtin_amdgcn_exp2f(S0[r]) * il; S1[r] = __builtin_amdgcn_exp2f(S1[r]) * il; }
        float lo0[4], hi0[4], lo1[4], hi1[4];
#pragma unroll
        for (int gq = 0; gq < 4; ++gq) { auto r0 = __builtin_amdgcn_permlane32_swap(__float_as_uint(S0[4 * gq + 3]), __float_as_uint(S0[4 * gq + 3]), false, false); auto r1 = __builtin_amdgcn_permlane32_swap(__float_as_uint(S1[4 * gq + 3]), __float_as_uint(S1[4 * gq + 3]), false, false);
            lo0[gq] = __uint_as_float(r0[0]); hi0[gq] = __uint_as_float(r0[1]); lo1[gq] = __uint_as_float(r1[0]); hi1[gq] = __uint_as_float(r1[1]); }
        LAS float* sl = slab + (hj * 32 + ct * 16) * 65 + tq;
#pragma unroll
        for (int gq = 0; gq < 4; ++gq) {
            const float s0 = (S0[4 * gq] + S0[4 * gq + 1]) + (S0[4 * gq + 2] + S0[4 * gq + 3]), s1 = (S1[4 * gq] + S1[4 * gq + 1]) + (S1[4 * gq + 2] + S1[4 * gq + 3]);
            const float pv0 = hi ? lo0[gq] : (gq == 0 ? carry : hi0[gq > 0 ? gq - 1 : 0]);
            const float pv1 = hi ? lo1[gq] : (gq == 0 ? hi0[3] : hi1[gq > 0 ? gq - 1 : 0]);
            sl[(2 * gq + hi) * 65] = s0 + pv0; sl[(8 + 2 * gq + hi) * 65] = s1 + pv1; }
        carry = hi1[3];
      } }
    __syncthreads();
    {
      const int ql = tid >> 3, j8 = tid & 7; float sc[4];
#pragma unroll
      for (int i = 0; i < 4; ++i) { const int n = 4 * j8 + i; const float v = (slab[(0 * 32 + n) * 65 + ql] + slab[(1 * 32 + n) * 65 + ql]) + (slab[(2 * 32 + n) * 65 + ql] + slab[(3 * 32 + n) * 65 + ql]);
          sc[i] = (n > qb) ? -1.0f : ((n == 0 || n == qb || n == qb - 1) ? 1.0e4f : v); }
      unsigned msk = 0u;
#pragma unroll 1
      for (int k = 0; k < 8; ++k) {
          float bv = sc[0]; int bi = 4 * j8;
#pragma unroll
          for (int i = 1; i < 4; ++i) if (sc[i] > bv) { bv = sc[i]; bi = 4 * j8 + i; }
          { float ov = lane_dpp<DPP_XOR1>(bv); int oi = lane_dpp_i<DPP_XOR1>(bi); if (ov > bv || (ov == bv && oi < bi)) { bv = ov; bi = oi; }
            ov = lane_dpp<DPP_XOR2>(bv); oi = lane_dpp_i<DPP_XOR2>(bi); if (ov > bv || (ov == bv && oi < bi)) { bv = ov; bi = oi; }
            ov = lane_dpp<DPP_HALF_MIRROR>(bv); oi = lane_dpp_i<DPP_HALF_MIRROR>(bi); if (ov > bv || (ov == bv && oi < bi)) { bv = ov; bi = oi; } }
#pragma unroll
          for (int i = 0; i < 4; ++i) if (bi == 4 * j8 + i) sc[i] = -3.0e38f;
          msk |= 1u << bi; }
      if (j8 == 0) selm[ql] = msk; }
    __syncthreads();
    const unsigned mask = selm[tq];
    { const bf16* Kg = PROJ + row0 * NPROJ + EC_KSL + g * 64; const bf16* Vg = PROJ + row0 * NPROJ + EC_VSL + g * 64;
      sm_init(sm, cbase); o[0] = (f32x16){0}; o[1] = (f32x16){0};
      auto step = [&](Stage& st, int n) __attribute__((always_inline)) {
        ldsp Ks = lds + NS_K + (n & 1) * 8192; ldsp Vs = lds + NS_V + (n & 1) * 8192;
        st_tile(st, Ks, Vs, wave, lane);
        __syncthreads();
        if (n + 1 <= qb) ld_tile(st, Kg + (size_t)(n + 1) * 64 * NPROJ, Vg + (size_t)(n + 1) * 64 * NPROJ, NPROJ, wave, lane);
        const bool sel = (mask >> n) & 1u;
        if (wave_any(sel)) {
            f32x16 S0, S1;
            S0 = sm_tuple(sm); S1 = S0; qk64(S0, S1, Ks, qr, r32, hi);
            nsa_logits<0>(S0, S1, qb - n, tq, hi, bdh, sel);
            v4u pa[4]; osm_lag<2>(S0, S1, sm, n == 0, o, wsf, r32, hi, pa, sel);
            pv64(o, Vs + vb, pa);
        }
      };
      Stage sa; ld_tile(sa, Kg, Vg, NPROJ, wave, lane);
#pragma unroll 1
      for (int n = 0; n <= qb; ++n) step(sa, n);
      rows_fma<false>(ofl, o, gt[1] / xhalf_sum(sm.l), wsf, r32, hi, lane); }
    { const bf16* Kg = PROJ + row0 * NPROJ + EC_KWN + g * 64; const bf16* Vg = PROJ + row0 * NPROJ + EC_VWN + g * 64;
      o[0] = (f32x16){0}; o[1] = (f32x16){0};
      const int n0 = qb > 4 ? qb - 4 : 0;
      __syncthreads();
      sm_init(sm, cbase);
      auto step = [&](Stage& st, int n) __attribute__((always_inline)) {
        ldsp Ks = lds + NS_K + (n & 1) * 8192; ldsp Vs = lds + NS_V + (n & 1) * 8192;
        st_tile(st, Ks, Vs, wave, lane);
        __syncthreads();
        if (n + 1 <= qb) ld_tile(st, Kg + (size_t)(n + 1) * 64 * NPROJ, Vg + (size_t)(n + 1) * 64 * NPROJ, NPROJ, wave, lane);
        f32x16 S0, S1;
        S0 = sm_tuple(sm); S1 = S0; qk64(S0, S1, Ks, qr, r32, hi);
        nsa_logits<1>(S0, S1, qb - n, tq, hi, bdh, true);
        v4u pa[4]; osm_lag<2>(S0, S1, sm, n == n0, o, wsf, r32, hi, pa);
        pv64(o, Vs + vb, pa);
      };
      Stage sa; ld_tile(sa, Kg + (size_t)n0 * 64 * NPROJ, Vg + (size_t)n0 * 64 * NPROJ, NPROJ, wave, lane);
#pragma unroll 1
      for (int n = n0; n <= qb; ++n) step(sa, n);
      rows_fma<false>(ofl, o, gt[2] / xhalf_sum(sm.l), wsf, r32, hi, lane); }
    asm volatile("s_waitcnt lgkmcnt(0)" ::: "memory");
    emit_o<2>(ofl, AO + (row0 + qb * 64 + sub * 32) * 1024 + 512 + h * 64, 1024, lane);
}

constexpr int CP_PART = 0, CP_H = 32768;
__device__ __forceinline__ void compress_unit(unsigned char* ws, ldsp lds, int b, int g, int kv, int rb, int e2, int tid) {
    const int lane = tid & 63, wave = __builtin_amdgcn_readfirstlane(tid >> 6), r32 = lane & 31, hi = lane >> 5, cb = wave & 1, kq = wave >> 1, mi = e2 * 2 + kv;
    const bf16* X = (const bf16*)(ws + WS_PROJ) + (size_t)b * T_ * NPROJ + (kv ? EC_VC : EC_KC) + g * 64;
    const bf16* W1t = (const bf16*)(ws + WS_CW1) + (size_t)mi * 64 * 2048; const bf16* W2t = (const bf16*)(ws + WS_CW2) + (size_t)mi * 64 * 64; const float* b1 = (const float*)(ws + WS_CB1) + mi * 64;
    bf16* OUTB = (bf16*)(ws + (kv ? WS_VCB : WS_KCB)) + (size_t)(b * 2 + g) * 128 * 64; float* OUTF = (float*)(ws + (kv ? WS_VC : WS_KC)) + (size_t)(b * 2 + g) * 127 * 64;
    LAS float* part = (LAS float*)(lds + CP_PART);
    LAS unsigned short* H = (LAS unsigned short*)(lds + CP_H);
    __syncthreads();
    const int c = rb * 32 + r32;
    f32x16 acc = (f32x16){0};
    const bf16* wrow = W1t + (size_t)(cb * 32 + r32) * 2048 + hi * 8;
#pragma unroll 8
    for (int k8 = 0; k8 < 32; ++k8) { const int ks = kq * 32 + k8, l = ks >> 2, d = (ks & 3) * 16 + hi * 8; int xr = 16 * c + l; xr = xr < 2047 ? xr : 2047;
        const bf16x8 af = *(const bf16x8*)(X + (size_t)xr * NPROJ + d); const bf16x8 bfr = *(const bf16x8*)(wrow + ks * 16);
        acc = __builtin_amdgcn_mfma_f32_32x32x16_bf16(af, bfr, acc, 0, 0, 0); }
#pragma unroll
    for (int r = 0; r < 16; ++r) part[((kq * 2 + cb) * 16 + r) * 64 + lane] = acc[r];
    __syncthreads();
    if (kq == 0) { const float bb = b1[cb * 32 + r32];
#pragma unroll
      for (int r = 0; r < 16; ++r) { const int cr = (r & 3) + 8 * (r >> 2) + 4 * hi;
          const float x = ((part[((0 * 2 + cb) * 16 + r) * 64 + lane] + part[((1 * 2 + cb) * 16 + r) * 64 + lane]) + (part[((2 * 2 + cb) * 16 + r) * 64 + lane] + part[((3 * 2 + cb) * 16 + r) * 64 + lane])) + bb;
          const float u2 = 0.7978845608028654f * (x + 0.044715f * x * x * x); const float hg = x * __builtin_amdgcn_rcpf(1.0f + __builtin_amdgcn_exp2f(-2.0f * LOG2E * u2)); H[cr * 64 + cb * 32 + r32] = (unsigned short)f2bf(hg); } }
    __syncthreads();
    if (kq == 0) {
        f32x16 acc2 = (f32x16){0};
#pragma unroll
        for (int ks = 0; ks < 4; ++ks) { const bf16x8 af = *(const LAS bf16x8*)(H + r32 * 64 + ks * 16 + hi * 8); const bf16x8 bfr = *(const bf16x8*)(W2t + (size_t)(cb * 32 + r32) * 64 + ks * 16 + hi * 8);
            acc2 = __builtin_amdgcn_mfma_f32_32x32x16_bf16(af, bfr, acc2, 0, 0, 0); }
#pragma unroll
        for (int r = 0; r < 16; ++r) { const int cr = rb * 32 + (r & 3) + 8 * (r >> 2) + 4 * hi; const float v = cr < 127 ? acc2[r] : 0.f;
            OUTB[(size_t)cr * 64 + cb * 32 + r32] = (bf16)f2bf(v); if (cr < 127) OUTF[(size_t)cr * 64 + cb * 32 + r32] = v; }
    }
}
static_assert(NS_OF + 65536 <= LDSCTL_OFF && SB_FLAG + 64 <= LDSCTL_OFF && XA_WSF + 1024 <= LDSCTL_OFF && FX_WSF + 1024 <= LDSCTL_OFF, "phase scratch below the barrier words");
}
constexpr int NPHASE = 2 + 9 * DEPTH_;
__host__ __device__ inline bool phase_empty(int ph) { if (ph == 0 || ph == NPHASE - 1) return false; const int l = (ph - 1) / 9, j = (ph - 1) % 9; return (j == 2) && (l & 1); }

struct GemmJob { int type; pg8::Gemm g; int cshift; pg8::bf16_t* O; int ldc; const float* ss; };

__device__ __forceinline__ GemmJob make_job(unsigned char* ws, float* X, int l, int j, int jb) {
    bf16* const XB = (bf16*)(ws + WS_XB); float* const SS = (float*)(ws + WS_SS); const bool even = (l & 1) == 0;
    if (j == 0) return GemmJob{even ? 0 : 1, pg8::Gemm{XB, (const bf16*)(ws + WS_WIN) + (size_t)l * NPROJ * 1024, M_, NPROJ, 1024}, 0, (bf16*)(ws + WS_PROJ), NPROJ, SS};
    if (j == 3) return GemmJob{3, pg8::Gemm{(const bf16*)(ws + WS_AO), (const bf16*)(ws + WS_WOUT) + (size_t)l * 1024 * 1024, M_, 1024, 1024}, 0, nullptr, 0, nullptr};
    if (j == 4) { if (jb == 0) return GemmJob{1, pg8::Gemm{XB, (const bf16*)(ws + WS_WQ) + (size_t)l * 512 * 1024, M_, 512, 1024}, 0, (bf16*)(ws + WS_QX), 512, SS};
                  return GemmJob{1, pg8::Gemm{(const bf16*)(ws + WS_MEMN), (const bf16*)(ws + WS_WKV) + (size_t)l * 1024 * 1024, MM_, 1024, 1024}, 128, (bf16*)(ws + WS_MEMKV), 1024, nullptr}; }
    if (j == 6) return GemmJob{3, pg8::Gemm{(const bf16*)(ws + WS_AOX), (const bf16*)(ws + WS_WO) + (size_t)l * 1024 * 512, M_, 1024, 512}, 0, nullptr, 0, nullptr};
    if (j == 7) return GemmJob{2, pg8::Gemm{XB, (const bf16*)(ws + WS_W1) + (size_t)l * 4096 * 1024, M_, FF_, 1024}, 0, (bf16*)(ws + WS_H), FF_, SS};
    return GemmJob{3, pg8::Gemm{(const bf16*)(ws + WS_H), (const bf16*)(ws + WS_W2) + (size_t)l * 1024 * 4096, M_, 1024, FF_}, 0, nullptr, 0, nullptr};
}

#define HAS(k) (PT < 0 || PT == (k))
template <int PT> __global__ void __launch_bounds__(NTHR, 2) fwd_kernel(Args args) {
    extern __shared__ __attribute__((aligned(16))) unsigned char lds_raw[];
    LAS unsigned char* lds = (LAS unsigned char*)lds_raw;
    volatile LAS unsigned* MISC = (volatile LAS unsigned*)(lds + MISC_OFF);
    const int tid0 = threadIdx.x;
    Frame F; F.lds = lds; F.tid = tid0; F.lane = tid0 & 63; F.wave = __builtin_amdgcn_readfirstlane(tid0 >> 6); F.G = gridDim.x;
    { const int bx = blockIdx.x; F.vcu = (F.G % 8 == 0) ? (bx % 8) * (F.G / 8) + bx / 8 : bx; }
    F.ws = args.ws;
    unsigned char* ws = args.ws; gu32* ctl = (gu32*)(ws + WS_CTL);
    for (int u = tid0; u < (LDS_BYTES - LDSCTL_OFF) / 4; u += NTHR) ((LAS unsigned*)(lds + LDSCTL_OFF))[u] = 0u;
    __syncthreads();
    const int lo = args.ph_lo, hi = args.ph_hi;
    int nne = 0; for (int p = lo; p < hi; ++p) nne += phase_empty(p) ? 0 : 1;
    XcdBarrier bar; bar.bar = (unsigned*)(ctl + CW_BAR); bar.x = 0; bar.st = nullptr;
    if (nne > 1) bar = xcd_barrier_post((unsigned*)(ctl + CW_BAR), MISC + 8);
    bool ran = false;
#if defined(PROBE_A)
    unsigned long long pr_t = __builtin_amdgcn_s_memrealtime(), pr_da = 0, pr_db = 0; int pr_last = (args.ph_lo == 0) ? 0 : -1;
#endif
    float* const X = args.out; bf16* const XB = (bf16*)(ws + WS_XB); float* const SS = (float*)(ws + WS_SS);
#if defined(PROBE_DELAY)
    { const unsigned long long t0_ = __builtin_amdgcn_s_memrealtime(); while (__builtin_amdgcn_s_memrealtime() - t0_ < PROBE_DELAY * 100ull) __builtin_amdgcn_s_sleep(8); }
#endif
    if (lo == 0) { if constexpr (HAS(0)) { int tid = threadIdx.x; asm volatile("" : "+v"(tid)); F.tid = tid; F.lane = tid & 63; F.wave = __builtin_amdgcn_readfirstlane(tid >> 6); p0_prologue(F, args);
#if defined(PROBE_PRO2)
        p0_prologue(F, args);
#endif
        } ran = true; }
    const int loop_lo = lo < 1 ? 1 : lo, loop_hi = hi < NPHASE - 1 ? hi : NPHASE - 1;
    for (int ph = loop_lo; ph < loop_hi; ++ph) {
        if (phase_empty(ph)) continue;
        if (ran) xcd_barrier(bar);
        ran = true;
#if defined(PROBE_A)
        { const unsigned long long now_ = __builtin_amdgcn_s_memrealtime(); if (pr_last == PROBE_A) pr_da = now_ - pr_t; if (pr_last == PROBE_B) pr_db = now_ - pr_t; pr_t = now_; pr_last = ph; }
#endif
        int tid = threadIdx.x; asm volatile("" : "+v"(tid));
        F.tid = tid; F.lane = tid & 63; F.wave = __builtin_amdgcn_readfirstlane(tid >> 6);
        const int l = (ph - 1) / 9, j = (ph - 1) % 9; const bool even = (l & 1) == 0;
        const int njobs = (j == 0 || j == 3 || j == 6 || j == 7 || j == 8) ? 1 : (j == 4 ? 2 : 0);
        for (int jb = 0; jb < njobs; ++jb) {
            const GemmJob J = make_job(ws, args.out, l, j, jb);
            pg8::StaticOrder S; S.init(J.g.M, J.g.N, F.G, (int)((blockIdx.x + F.G - J.cshift) % F.G));
            float* const LF = (float*)(ws + WS_LF); float* const GT = (float*)(ws + WS_GT); const float* bfg = args.b_forget + (l >> 1) * 8;
            if (J.type == 0) { if constexpr (HAS(1)) { pg8::EpiBf<0, true> E{J.O, J.ldc, J.ss, LF, GT, bfg}; pg8::gemm_phase<pg8::EpiBf<0, true>, pg8::StaticOrder, true, true>(lds + RING_OFF, J.g, S, E); } }
            else if (J.type == 1) { if constexpr (HAS(2)) { pg8::EpiBf<0, false> E{J.O, J.ldc, J.ss, nullptr, nullptr, nullptr}; pg8::gemm_phase<pg8::EpiBf<0, false>, pg8::StaticOrder, true, true>(lds + RING_OFF, J.g, S, E); } }
            else if (J.type == 2) { if constexpr (HAS(3)) { pg8::EpiBf<1, false> E{J.O, J.ldc, J.ss, nullptr, nullptr, nullptr}; pg8::gemm_phase<pg8::EpiBf<1, false>, pg8::StaticOrder, true, true>(lds + RING_OFF, J.g, S, E); } }
            else { if constexpr (HAS(4)) { pg8::EpiResid E{(l == 0 && j == 3) ? args.x : (const float*)nullptr, (l == DEPTH_ - 1 && j == 8) ? X : (float*)nullptr, XB, SS}; pg8::gemm_phase<pg8::EpiResid, pg8::StaticOrder, false, true>(lds + RING_OFF, J.g, S, E); } }
        }
        if (j == 4 && l + 1 < DEPTH_ && blockIdx.x >= 160) { if constexpr (HAS(2)) convert_layer_weights(F, args, l + 1, ((int)blockIdx.x - 160) * NWAVES + F.wave, ((int)F.G - 160) * NWAVES); }
        if (j == 1) {
            if (even) { if constexpr (HAS(5)) {
#if USE_MFMA_FOX
                for (int u = blockIdx.x; u < 512; u += F.G) { const int c = u & 255, i = u >> 8, s = c & 3; at::fox_unit(ws, lds, c >> 5, (c >> 2) & 7, i ? 7 - s : s, tid); }
#else
                for (int u = blockIdx.x; u < 256; u += F.G) fox_naive_unit(ws, lds, u, tid);
#endif
#if USE_MFMA_CMP
                for (int u = blockIdx.x; u < 128; u += F.G) at::compress_unit(ws, lds, u >> 4, (u >> 3) & 1, (u >> 2) & 1, u & 3, l >> 1, tid);
#else
                for (int u = blockIdx.x; u < 256; u += F.G) compress_naive_unit(args, ws, lds, u, l, tid);
#endif
            } }
            else { if constexpr (HAS(6)) {
#if USE_MFMA_SB
                for (int u = blockIdx.x; u < 1024; u += F.G) at::sb_unit(ws, lds, u >> 7, (u >> 4) & 7, 15 - (u & 15), tid);
#else
                for (int u = blockIdx.x; u < 512; u += F.G) sb_naive_unit(ws, lds, u, tid);
#endif
            } }
        } else if (j == 2) { if constexpr (HAS(7)) {
#if USE_MFMA_NSA
            for (int u = blockIdx.x; u < 512; u += F.G) { const int c = u & 255, i = u >> 8, s = c & 15; at::nsa_unit(args.rel_bias, ws, lds, c >> 5, (c >> 4) & 1, i ? 31 - s : s, tid); }
#else
            for (int u = blockIdx.x; u < 256; u += F.G) nsa_naive_unit(args, ws, lds, u, tid);
#endif
        } }
        else if (j == 5) { if constexpr (HAS(8)) {
#if USE_MFMA_XA
            for (int u = blockIdx.x; u < 256; u += F.G) at::xattn_unit(ws, lds, u >> 5, (u >> 3) & 3, u & 7, tid);
#else
            for (int u = blockIdx.x; u < 256; u += F.G) xattn_naive_unit(ws, lds, u, tid);
#endif
        } }
    }
    if (hi == NPHASE) { if (ran) xcd_barrier(bar);
        if constexpr (HAS(9)) { int tid = threadIdx.x; asm volatile("" : "+v"(tid)); F.tid = tid; F.lane = tid & 63; F.wave = __builtin_amdgcn_readfirstlane(tid >> 6); final_norm(F, args); } }
#if defined(PROBE_BARRIERS)
    for (int i = 0; i < PROBE_BARRIERS; ++i) xcd_barrier(bar);
#endif
#if defined(SUBPROBE)
    if (blockIdx.x == 0) { LAS unsigned long long* acc = (LAS unsigned long long*)(lds + LDSCTL_OFF); __syncthreads();
        unsigned long long qa = (acc[SUB_A] + SUB_Q / 2) / SUB_Q, qb2 = (acc[SUB_B] + SUB_Q / 2) / SUB_Q; if (qa > 63) qa = 63; if (qb2 > 63) qb2 = 63;
        const unsigned long long target = __builtin_amdgcn_s_memrealtime() + 4000ull * (qa + 64ull * qb2);
        while (__builtin_amdgcn_s_memrealtime() < target) __builtin_amdgcn_s_sleep(32); }
#endif
#if defined(PROBE_A)
    { const unsigned long long now_ = __builtin_amdgcn_s_memrealtime(); if (pr_last == PROBE_A) pr_da = now_ - pr_t; if (pr_last == PROBE_B) pr_db = now_ - pr_t;
      if (blockIdx.x == 0) { unsigned long long qa = (pr_da + 400) / 800, qb2 = (pr_db + 400) / 800; if (qa > 63) qa = 63; if (qb2 > 63) qb2 = 63;
          const unsigned long long target = now_ + 4000ull * (qa + 64ull * qb2);
          while (__builtin_amdgcn_s_memrealtime() < target) __builtin_amdgcn_s_sleep(32); } }
#endif
}

#ifndef MK_SINGLE
#define MK_SINGLE 0
#endif
#if MK_SINGLE
constexpr int NKERN = 1;
static const void* kern_ptr(int) { return (const void*)fwd_kernel<-1>; }
#else
constexpr int NKERN = 10;
static const void* kern_ptr(int k) {
    switch (k) { case 0: return (const void*)fwd_kernel<0>; case 1: return (const void*)fwd_kernel<1>; case 2: return (const void*)fwd_kernel<2>; case 3: return (const void*)fwd_kernel<3>; case 4: return (const void*)fwd_kernel<4>;
                 case 5: return (const void*)fwd_kernel<5>; case 6: return (const void*)fwd_kernel<6>; case 7: return (const void*)fwd_kernel<7>; case 8: return (const void*)fwd_kernel<8>; default: return (const void*)fwd_kernel<9>; }
}
static int phase_kernel(int ph) {
    if (ph == 0) return 0; if (ph == NPHASE - 1) return 9;
    const int l = (ph - 1) / 9, j = (ph - 1) % 9; const bool even = (l & 1) == 0;
    switch (j) { case 0: return even ? 1 : 2; case 1: return even ? 5 : 6; case 2: return 7; case 3: return 4; case 4: return 2; case 5: return 8; case 6: return 4; case 7: return 3; default: return 4; }
}
#endif
extern "C" void kernel_launch(void* const* d_in, const int* in_sizes, int n_in, void* d_out, int out_size, void* d_ws, size_t ws_size, hipStream_t stream) {
    static int grid = 0;
    if (grid == 0) {
        if (n_in != 24 || in_sizes[0] != M_ * D_ || out_size != M_ * D_ || ws_size < WS_END) { fprintf(stderr, "kernel_launch: unexpected problem (n_in %d, ws %zu); nothing launched\n", n_in, ws_size); grid = -1; return; }
        int dev = 0, cus = 0;
        if (hipGetDevice(&dev) != hipSuccess || hipDeviceGetAttribute(&cus, hipDeviceAttributeMultiprocessorCount, dev) != hipSuccess) { grid = -1; return; }
        for (int k = 0; k < NKERN; ++k) if (hipFuncSetAttribute(kern_ptr(k), hipFuncAttributeMaxDynamicSharedMemorySize, LDS_BYTES) != hipSuccess) { fprintf(stderr, "kernel_launch: hipFuncSetAttribute failed\n"); grid = -1; return; }
        (void)hipGetLastError();
        grid = cus;
    }
    if (grid < 0) return;
    (void)hipMemsetAsync((char*)d_ws + WS_CTL, 0, CTL_ZERO_BYTES, stream);
    Args a{};
    const float** ap = (const float**)&a;
    for (int i = 0; i < 24; ++i) ap[i] = (const float*)d_in[i];
    a.out = (float*)d_out; a.ws = (unsigned char*)d_ws;
#if MK_SINGLE
    a.ph_lo = 0; a.ph_hi = NPHASE;
    hipLaunchKernelGGL(fwd_kernel<-1>, dim3(grid), dim3(NTHR), LDS_BYTES, stream, a);
#else
    for (int ph = 0; ph < NPHASE; ++ph) { if (phase_empty(ph)) continue; a.ph_lo = ph; a.ph_hi = ph + 1; void* kargs[] = {&a};
        (void)hipLaunchKernel(kern_ptr(phase_kernel(ph)), dim3(grid), dim3(NTHR), kargs, LDS_BYTES, stream); }
#endif
}
```
